# Optimizing an MI355X kernel written in HIP

```python
import jax, jax.numpy as jnp
from jax import lax
import numpy as np

D_MODEL = 1024
BATCH = 32
SEQ = 256
DEPTH = 4
DEC_BATCH = 4
DEC_SEQ = 1024
PAST_LEN = 512

GRID_W = 64
N_HEADS = 8
N_KV_HEADS = 2
HEAD_DIM = 64
GQA_GROUP = N_HEADS // N_KV_HEADS
AXIS_ROPE_DIM = HEAD_DIM // 2
ROPE_THETA = 10000.0
Q_BLOCK = 128
ATT_Q = N_HEADS * HEAD_DIM
ATT_KV = N_KV_HEADS * HEAD_DIM
CONV_CH = 512
CONV_K = 31
FOURIER_GROUPS = 4
FOURIER_GROUP_CH = 128
FOURIER_CH = FOURIER_GROUPS * FOURIER_GROUP_CH
SGU_GROUPS = 4
SGU_GROUP_CH = 128
SGU_CH = SGU_GROUPS * SGU_GROUP_CH
CHUNK = 128
FFN_DIM = 2816
N_SUBLAYERS = 3
N_MOD = 3 * N_SUBLAYERS
EVEN_IN = ATT_Q + 2 * ATT_KV + 2 * CONV_CH
EVEN_OUT = ATT_Q + CONV_CH
ODD_IN = FOURIER_CH + 2 * SGU_CH
ODD_OUT = FOURIER_CH + SGU_CH
N_EVEN = (DEPTH + 1) // 2
N_ODD = DEPTH // 2
RMS_EPS = 1e-6
LN_EPS = 1e-5

kernel_name = 'hybrid_diffusion_prefix_trunk_step'


def rms_norm(x, g):
    xf = x.astype(jnp.float32)
    y = xf * lax.rsqrt(jnp.mean(xf * xf, axis=-1, keepdims=True) + RMS_EPS)
    return (y * g.astype(jnp.float32)).astype(x.dtype)


def layer_norm(x, g, b):
    xf = x.astype(jnp.float32)
    mu = jnp.mean(xf, axis=-1, keepdims=True)
    xc = xf - mu
    var = jnp.mean(xc * xc, axis=-1, keepdims=True)
    return (xc * lax.rsqrt(var + LN_EPS) * g.astype(jnp.float32) + b.astype(jnp.float32)).astype(x.dtype)


def adaln(cond, w, b):
    return (jax.nn.silu(cond) @ w + b).reshape(cond.shape[0], N_MOD, D_MODEL)


def modulate(x, g, shift, scale):
    return rms_norm(x, g) * (1 + scale) + shift


def swiglu(h, w_in, w_out):
    gate, up = jnp.split(h @ w_in, 2, axis=-1)
    return (jax.nn.silu(gate) * up) @ w_out


def rope_tables(rows):
    t = jnp.arange(rows * GRID_W)
    row = (t // GRID_W).astype(jnp.float32)
    col = (t % GRID_W).astype(jnp.float32)
    inv_freq = 1.0 / (ROPE_THETA ** (jnp.arange(0, AXIS_ROPE_DIM, 2, dtype=jnp.float32) / AXIS_ROPE_DIM))
    ang = jnp.concatenate([row[:, None] * inv_freq, col[:, None] * inv_freq], axis=-1)
    return jnp.cos(ang), jnp.sin(ang)


def apply_rope(x, cos, sin):
    xf = x.astype(jnp.float32).reshape(*x.shape[:-1], HEAD_DIM // 2, 2)
    x0, x1 = xf[..., 0], xf[..., 1]
    cs = cos[None, :, None, :]
    sn = sin[None, :, None, :]
    out = jnp.stack([x0 * cs - x1 * sn, x0 * sn + x1 * cs], axis=-1)
    return out.reshape(x.shape).astype(x.dtype)


def block_attention(q, k, v):
    bsz, lq = q.shape[0], q.shape[1]
    nb = lq // Q_BLOCK
    qb = q.reshape(bsz, nb, Q_BLOCK, N_KV_HEADS, GQA_GROUP, HEAD_DIM).swapaxes(0, 1)
    scale = HEAD_DIM ** -0.5

    def one_block(qblk):
        s = jnp.einsum('bqkgd,bskd->bkgqs', qblk, k).astype(jnp.float32) * scale
        p = jax.nn.softmax(s, axis=-1).astype(v.dtype)
        return jnp.einsum('bkgqs,bskd->bqkgd', p, v)

    out = lax.map(one_block, qb)
    return out.swapaxes(0, 1).reshape(bsz, lq, ATT_Q)


def depthwise_conv(x, w, b):
    y = lax.conv_general_dilated(
        x, w[:, None, :], window_strides=(1,), padding=[(CONV_K // 2, CONV_K // 2)],
        dimension_numbers=('NWC', 'WIO', 'NWC'), feature_group_count=x.shape[-1])
    return y + b


def even_mixer(h, w_in, w_out, q_g, k_g, conv_w, conv_b, cn_g, cn_b, rope, ctx_kv):
    bsz, length, _ = h.shape
    q, k, v, a = jnp.split(h @ w_in, [ATT_Q, ATT_Q + ATT_KV, ATT_Q + 2 * ATT_KV], axis=-1)
    q = rms_norm(q.reshape(bsz, length, N_HEADS, HEAD_DIM), q_g)
    k = rms_norm(k.reshape(bsz, length, N_KV_HEADS, HEAD_DIM), k_g)
    v = v.reshape(bsz, length, N_KV_HEADS, HEAD_DIM)
    if ctx_kv is None:
        own_kv = (k, v)
        attn = block_attention(q, k, v)
    else:
        cos, sin = rope
        ck, cv = ctx_kv
        attn = block_attention(apply_rope(q, cos, sin),
                               jnp.concatenate([ck, apply_rope(k, cos, sin)], axis=1),
                               jnp.concatenate([cv, v], axis=1))
        own_kv = None
    glu = a[..., :CONV_CH] * jax.nn.sigmoid(a[..., CONV_CH:])
    conv = jax.nn.silu(layer_norm(depthwise_conv(glu, conv_w, conv_b), cn_g, cn_b))
    return jnp.concatenate([attn, conv], axis=-1) @ w_out, own_kv


def odd_mixer(h, w_in, w_out, sn_g, sn_b, w_s, b_s):
    bsz, length, _ = h.shape
    f, u, v = jnp.split(h @ w_in, [FOURIER_CH, FOURIER_CH + SGU_CH], axis=-1)
    f = f.reshape(bsz, length, FOURIER_GROUPS, FOURIER_GROUP_CH).astype(jnp.float32)
    four = jnp.fft.fft2(f, axes=(1, 3), norm='ortho').real.astype(h.dtype).reshape(bsz, length, FOURIER_CH)
    v = layer_norm(v, sn_g, sn_b).reshape(bsz, length // CHUNK, CHUNK, SGU_GROUPS, SGU_GROUP_CH)
    v = jnp.einsum('gpq,bnqgc->bnpgc', w_s, v) + jnp.swapaxes(b_s, 0, 1)[:, :, None]
    sgu = u * v.reshape(bsz, length, SGU_CH)
    return jnp.concatenate([four, sgu], axis=-1) @ w_out, None


def macaron_layer(x, mod, norm_g, ffn_in, ffn_out, mixer):
    m = mod[:, :, None, :]
    x = x + 0.5 * m[:, 2] * swiglu(modulate(x, norm_g[0], m[:, 0], m[:, 1]), ffn_in[0], ffn_out[0])
    mixed, own_kv = mixer(modulate(x, norm_g[1], m[:, 3], m[:, 4]))
    x = x + m[:, 5] * mixed
    x = x + 0.5 * m[:, 8] * swiglu(modulate(x, norm_g[2], m[:, 6], m[:, 7]), ffn_in[1], ffn_out[1])
    return x, own_kv


def run_stream(x, cond, rope, ctx_k, ctx_v, w_mod, b_mod, norm_g, ffn_w_in, ffn_w_out,
               ev_w_in, ev_w_out, q_norm_g, k_norm_g, conv_w, conv_b, conv_norm_g, conv_norm_b,
               od_w_in, od_w_out, sgu_norm_g, sgu_norm_b, sgu_w, sgu_b):
    ks, vs = [], []
    for layer in range(DEPTH):
        mod = adaln(cond, w_mod[layer], b_mod[layer])
        j = layer // 2
        if layer % 2 == 0:
            ctx_kv = None if ctx_k is None else (ctx_k[:, j], ctx_v[:, j])

            def mixer(h):
                return even_mixer(h, ev_w_in[j], ev_w_out[j], q_norm_g[j], k_norm_g[j], conv_w[j],
                                  conv_b[j], conv_norm_g[j], conv_norm_b[j], rope, ctx_kv)
        else:
            def mixer(h):
                return odd_mixer(h, od_w_in[j], od_w_out[j], sgu_norm_g[j], sgu_norm_b[j],
                                 sgu_w[j], sgu_b[j])
        x, own_kv = macaron_layer(x, mod, norm_g[layer], ffn_w_in[layer], ffn_w_out[layer], mixer)
        if own_kv is not None:
            ks.append(own_kv[0])
            vs.append(own_kv[1])
    return x, ks, vs


def setup_inputs(seed: int = 0) -> dict:
    key = jax.random.key(seed)
    ks = jax.random.split(key, 25)

    def nrm(k, shape, s):
        return jax.random.normal(k, shape, jnp.float32) * s

    return {
        'x_prompt': nrm(ks[0], (BATCH, SEQ, D_MODEL), 1.0),
        'x_sample': nrm(ks[1], (DEC_BATCH, DEC_SEQ, D_MODEL), 1.0),
        'cache_k': nrm(ks[2], (DEC_BATCH, N_EVEN, PAST_LEN, N_KV_HEADS, HEAD_DIM), 1.0),
        'cache_v': nrm(ks[3], (DEC_BATCH, N_EVEN, PAST_LEN, N_KV_HEADS, HEAD_DIM), 1.0),
        'c': nrm(ks[4], (DEC_BATCH, D_MODEL), 1.0),
        'c_ctx': nrm(ks[5], (D_MODEL,), 1.0),
        'w_mod': nrm(ks[6], (DEPTH, D_MODEL, N_MOD * D_MODEL), 0.3 * D_MODEL ** -0.5),
        'b_mod': nrm(ks[7], (DEPTH, N_MOD * D_MODEL), 0.01),
        'norm_g': 1.0 + nrm(ks[8], (DEPTH, N_SUBLAYERS, D_MODEL), 0.05),
        'ffn_w_in': nrm(ks[9], (DEPTH, 2, D_MODEL, 2 * FFN_DIM), D_MODEL ** -0.5),
        'ffn_w_out': nrm(ks[10], (DEPTH, 2, FFN_DIM, D_MODEL), FFN_DIM ** -0.5),
        'ev_w_in': nrm(ks[11], (N_EVEN, D_MODEL, EVEN_IN), D_MODEL ** -0.5),
        'ev_w_out': nrm(ks[12], (N_EVEN, EVEN_OUT, D_MODEL), EVEN_OUT ** -0.5),
        'q_norm_g': 1.0 + nrm(ks[13], (N_EVEN, HEAD_DIM), 0.05),
        'k_norm_g': 1.0 + nrm(ks[14], (N_EVEN, HEAD_DIM), 0.05),
        'conv_w': nrm(ks[15], (N_EVEN, CONV_K, CONV_CH), CONV_K ** -0.5),
        'conv_b': nrm(ks[16], (N_EVEN, CONV_CH), 0.01),
        'conv_norm_g': 1.0 + nrm(ks[17], (N_EVEN, CONV_CH), 0.05),
        'conv_norm_b': nrm(ks[18], (N_EVEN, CONV_CH), 0.01),
        'od_w_in': nrm(ks[19], (N_ODD, D_MODEL, ODD_IN), D_MODEL ** -0.5),
        'od_w_out': nrm(ks[20], (N_ODD, ODD_OUT, D_MODEL), ODD_OUT ** -0.5),
        'sgu_norm_g': 1.0 + nrm(ks[21], (N_ODD, SGU_CH), 0.05),
        'sgu_norm_b': nrm(ks[22], (N_ODD, SGU_CH), 0.01),
        'sgu_w': nrm(ks[23], (N_ODD, SGU_GROUPS, CHUNK, CHUNK), CHUNK ** -0.5),
        'sgu_b': 1.0 + nrm(ks[24], (N_ODD, SGU_GROUPS, CHUNK), 0.01),
    }


def reference(x_prompt, x_sample, cache_k, cache_v, c, c_ctx, w_mod, b_mod, norm_g, ffn_w_in,
              ffn_w_out, ev_w_in, ev_w_out, q_norm_g, k_norm_g, conv_w, conv_b, conv_norm_g,
              conv_norm_b, od_w_in, od_w_out, sgu_norm_g, sgu_norm_b, sgu_w, sgu_b):
    weights = (w_mod, b_mod, norm_g, ffn_w_in, ffn_w_out, ev_w_in, ev_w_out, q_norm_g, k_norm_g,
               conv_w, conv_b, conv_norm_g, conv_norm_b, od_w_in, od_w_out, sgu_norm_g,
               sgu_norm_b, sgu_w, sgu_b)
    y_prompt, ctx_ks, ctx_vs = run_stream(x_prompt, c_ctx[None, :], None, None, None, *weights)
    new_cache_k = jnp.stack(ctx_ks, axis=1)
    new_cache_v = jnp.stack(ctx_vs, axis=1)
    rows = x_sample.shape[1] // GRID_W
    rope = rope_tables(rows)
    y_sample, _, _ = run_stream(x_sample, c, rope, cache_k, cache_v, *weights)
    return (y_prompt, y_sample, new_cache_k, new_cache_v)
```

```cpp
#include <hip/hip_runtime.h>
#include <hip/hip_cooperative_groups.h>
#include <cstdio>
#include <cstdint>
namespace cg = cooperative_groups;

#ifndef DUP_MASK
#define DUP_MASK 0
#endif
#define DUPN(bit) ((DUP_MASK & (bit)) ? 2 : 1)
#ifndef ONE_LAUNCH
#define ONE_LAUNCH 1
#endif

#define LAS __attribute__((address_space(3)))
typedef unsigned short bf16_t;
typedef short bf16x8 __attribute__((ext_vector_type(8)));
typedef float f32x4 __attribute__((ext_vector_type(4)));
typedef unsigned u32x4 __attribute__((ext_vector_type(4)));
typedef unsigned u32x2 __attribute__((ext_vector_type(2)));

constexpr int D = 1024, TP = 8192, TS = 4096, T = TP + TS, FFN = 2816;
constexpr int NPH = 30;
#ifndef GT_ROWS
#define GT_ROWS 192
#endif
constexpr int GT = GT_ROWS;
constexpr float C2 = 0.125f * 1.4426950408889634f;

constexpr size_t MiB = 1u << 20;
constexpr size_t WS_WF1 = 0, WS_WF2 = 88 * MiB, WS_WEI = 132 * MiB, WS_WEO = 139 * MiB, WS_WOI = 143 * MiB, WS_WOO = 151 * MiB;
constexpr size_t WS_D256 = 155 * MiB, WS_D1024 = 156 * MiB, WS_MOD = 160 * MiB, WS_ROPE = 161 * MiB, WS_X = 162 * MiB, WS_H = 210 * MiB;
constexpr size_t WS_HID = 234 * MiB, WS_Q = 300 * MiB, WS_KP = 312 * MiB, WS_VPT = 314 * MiB, WS_KS = 316 * MiB, WS_VST = 319 * MiB;
constexpr size_t WS_GLU = 322 * MiB, WS_MIX = 346 * MiB, WS_U = 370 * MiB, WS_V = 382 * MiB, WS_FTP = 406 * MiB, WS_FTS = 422 * MiB, WS_BAR = 430 * MiB, WS_RSS = 431 * MiB, WS_GS = 432 * MiB, WS_SW = 433 * MiB, WS_END = 435 * MiB;
constexpr int SW_EI = 8 * 5 * 5632, SW_OI = SW_EI + 2 * 5 * 1792;

constexpr int LDS_BYTES = 131072 + 2048;

struct Params { const float* in[25]; float* out; unsigned char* ws; int ph_lo, ph_hi; };

__device__ __forceinline__ unsigned cvt_pk_bf16(float lo, float hi) { unsigned r; asm volatile("v_cvt_pk_bf16_f32 %0, %1, %2" : "=v"(r) : "v"(lo), "v"(hi)); return r; }
__device__ __forceinline__ bf16_t f2bf(float f) { return (bf16_t)(cvt_pk_bf16(f, 0.f) & 0xffffu); }
__device__ __forceinline__ float bf2f(unsigned h) { return __builtin_bit_cast(float, h << 16); }
__device__ __forceinline__ float wave_sum(float v) {
#pragma unroll
    for (int o = 1; o < 64; o <<= 1) v += __shfl_xor(v, o);
    return v;
}
__device__ __forceinline__ float sigmoidf_(float x) { return __builtin_amdgcn_rcpf(1.f + __expf(-x)); }
__device__ __forceinline__ float siluf_(float x) { return x * sigmoidf_(x); }

namespace pg8 {
constexpr int BM = 256, BK = 64, HALF = 128, HTB = HALF * BK * 2, NXCD = 8, WGM = 8;
__device__ __forceinline__ int lds_byte(int r, int c) { const int st = (r >> 4) * 2 + (c >> 5), rr = r & 15, cc = c & 31, ob = rr * 64 + cc * 2; return st * 1024 + (ob ^ (((ob >> 9) & 1) << 5)); }
__device__ __forceinline__ void stage_rc(int b, int& R, int& C) { const int st = b / 1024, sb = b % 1024, swz = sb ^ (((sb >> 9) & 1) << 5); R = (st >> 1) * 16 + swz / 64; C = (st & 1) * 32 + (swz % 64) / 2; }
__device__ __forceinline__ int perm32(int rho) { const int n = rho >> 4, i = rho & 15; return 8 * (i >> 2) + 4 * n + (i & 3); }

struct Unit { int pm, pn; };
struct Gemm { const bf16_t* A; const bf16_t* Bt; int M, N, K; };

struct StaticOrder {
    int nM, nN, nwg, G, c;
    __device__ void init(int M, int N, int G_, int c_, int TM = 256) { nM = M / TM; nN = N / BM; nwg = nM * nN; G = G_; c = c_; }
    __device__ bool next(int i, Unit& u) const {
        const long L = (long)i * G + c; if (L >= nwg) return false;
        int wgid = (int)L; { const int q = nwg / NXCD, r = nwg % NXCD, xcd = wgid % NXCD, off = wgid / NXCD; wgid = (xcd < r ? xcd * (q + 1) : r * (q + 1) + (xcd - r) * q) + off; }
        const int nig = WGM * nN, gid = wgid / nig, fm = gid * WGM, gsz = (nM - fm) < WGM ? (nM - fm) : WGM;
        u.pm = fm + ((wgid % nig) % gsz); u.pn = (wgid % nig) / gsz; return true;
    }
};

template <int TM, class Epi>
__device__ __forceinline__ void gemm_phase(LAS unsigned char* lds, const Gemm g, const StaticOrder& S, const Epi& E) {
    int tid_ = threadIdx.x; asm volatile("" : "+v"(tid_));
    const int tid = tid_, wid = __builtin_amdgcn_readfirstlane(tid >> 6), lane = tid & 63, wr = wid >> 2, wc = wid & 3, fr = lane & 15, fq = lane >> 4;
    const int K = g.K, nt = K / BK;
    constexpr int HA = TM / 2, HTA = HA * BK * 2, MT = TM / 64;
    constexpr int NA = (TM == 128) ? 1 : 2;
    unsigned voffA[2], voffB[2], ldsA[2];
#pragma unroll
    for (int i = 0; i < 2; ++i) { int R, C; stage_rc(tid * 16 + i * 8192, R, C); const int Rb = (R & ~31) + perm32(R & 31);
        voffB[i] = (unsigned)(Rb * K + C) * 2u;
        const bool okA = (tid * 16 + i * 8192) < HTA;
        int Ra, Ca; stage_rc(tid * 16 + (okA ? i * 8192 : 0), Ra, Ca);
        voffA[i] = (unsigned)(Ra * K + Ca) * 2u; ldsA[i] = okA ? (unsigned)i * 8192u : 0u; }
    const size_t kstep = (size_t)(BK * 2);
    const size_t hstep = (size_t)HALF * K * 2;
    const size_t tstep = 2 * hstep;
    const size_t hstepA = (size_t)HA * K * 2, tstepA = 2 * hstepA;
    const unsigned ldsw = (unsigned)wid * 1024u;
    const int aoff = lds_byte(wr * (HA / 2) + fr, fq * 8), boff = lds_byte(wc * 32 + fr, fq * 8);
#define PG8_SA(b, h) (((b) * 2 + (h)) * HTA)
#define PG8_SB(b, h) (4 * HTA + ((b) * 2 + (h)) * HTB)
#define PG8_STAGE(bufoff, gbase, voff) do { _Pragma("unroll") for (int _i = 0; _i < 2; ++_i) \
        __builtin_amdgcn_global_load_lds((const unsigned*)((const char*)(gbase) + (voff)[_i]), (LAS unsigned*)(lds + (bufoff) + ldsw + _i * 8192), 16, 0, 0); } while (0)
#define PG8_STAGEA(bufoff, gbase) do { _Pragma("unroll") for (int _i = 0; _i < NA; ++_i) \
        __builtin_amdgcn_global_load_lds((const unsigned*)((const char*)(gbase) + voffA[_i]), (LAS unsigned*)(lds + (bufoff) + ldsw + ldsA[_i]), 16, 0, 0); } while (0)
#define PG8_LDA(dst, b, h) do { _Pragma("unroll") for (int m = 0; m < MT; ++m) _Pragma("unroll") for (int k = 0; k < 2; ++k) dst[m][k] = *(const LAS bf16x8*)(lds + PG8_SA(b, h) + aoff + m * 2048 + k * 1024); } while (0)
#define PG8_LDB(dst, b, h) do { _Pragma("unroll") for (int n = 0; n < 2; ++n) _Pragma("unroll") for (int k = 0; k < 2; ++k) dst[n][k] = *(const LAS bf16x8*)(lds + PG8_SB(b, h) + boff + n * 2048 + k * 1024); } while (0)
#define PG8_MMA(ai, bj, At, Bt) do { __builtin_amdgcn_s_setprio(1); _Pragma("unroll") for (int m = 0; m < MT; ++m) _Pragma("unroll") for (int n = 0; n < 2; ++n) _Pragma("unroll") for (int k = 0; k < 2; ++k) \
        acc[ai][bj][m][n] = __builtin_amdgcn_mfma_f32_16x16x32_bf16(Bt[n][k], At[m][k], acc[ai][bj][m][n], 0, 0, 0); __builtin_amdgcn_s_setprio(0); } while (0)
#define PG8_WAIT_V(n) asm volatile("s_waitcnt vmcnt(" #n ")" ::: "memory")
#define PG8_WAIT_LOOP do { if constexpr (NA == 2) PG8_WAIT_V(8); else PG8_WAIT_V(6); } while (0)
#define PG8_WAIT_L(n) asm volatile("s_waitcnt lgkmcnt(" #n ")" ::: "memory")
#define PG8_BAR __builtin_amdgcn_s_barrier()
#define PG8_SCHED __builtin_amdgcn_sched_barrier(0)
    Unit cur, nxt; int ui = 0;
    if (!S.next(0, cur)) return;
    f32x4 acc[2][2][MT][2];
#pragma unroll
    for (int a = 0; a < 2; ++a)
#pragma unroll
        for (int b = 0; b < 2; ++b)
#pragma unroll
            for (int m = 0; m < MT; ++m)
#pragma unroll
                for (int n = 0; n < 2; ++n) acc[a][b][m][n] = (f32x4){0.f, 0.f, 0.f, 0.f};
    bf16x8 At[MT][2], B0[2][2], B1[2][2];
    const char* cA = (const char*)g.A + (size_t)cur.pm * tstepA; const char* cB = (const char*)g.Bt + (size_t)cur.pn * tstep;
    PG8_STAGE(PG8_SB(0, 0), cB, voffB); PG8_STAGE(PG8_SB(0, 1), cB + hstep, voffB); PG8_STAGEA(PG8_SA(0, 0), cA); PG8_STAGEA(PG8_SA(0, 1), cA + hstepA);
    if (wr == 1) PG8_BAR;
    if constexpr (NA == 2) PG8_WAIT_V(2); else PG8_WAIT_V(1);
    PG8_BAR;
    PG8_STAGE(PG8_SB(1, 0), cB + kstep, voffB); PG8_STAGEA(PG8_SA(1, 0), cA + kstep); PG8_STAGE(PG8_SB(1, 1), cB + hstep + kstep, voffB);
    if constexpr (NA == 2) PG8_WAIT_V(6); else PG8_WAIT_V(5);
    PG8_BAR;
    for (;;) {
        const bool has_next = S.next(ui + 1, nxt);
        const char* nA = has_next ? (const char*)g.A + (size_t)nxt.pm * tstepA : cA; const char* nB = has_next ? (const char*)g.Bt + (size_t)nxt.pn * tstep : cB;
        for (int t = 0; t < nt; t += 2) {
            const bool last = (t == nt - 2);
            const char* a1 = cA + (size_t)(t + 1) * kstep;
            const char* a2 = last ? nA : cA + (size_t)(t + 2) * kstep; const char* b2 = last ? nB : cB + (size_t)(t + 2) * kstep;
            const char* a3 = a2 + kstep; const char* b3 = b2 + kstep;
            PG8_LDB(B0, 0, 0); PG8_LDB(B1, 0, 1); PG8_SCHED; PG8_LDA(At, 0, 0); PG8_STAGEA(PG8_SA(1, 1), a1 + hstepA);
            PG8_WAIT_LOOP; PG8_WAIT_L(0); PG8_BAR; PG8_MMA(0, 0, At, B0); PG8_MMA(0, 1, At, B1); PG8_BAR; PG8_SCHED;
            PG8_LDA(At, 0, 1); PG8_STAGE(PG8_SB(0, 0), b2, voffB); PG8_STAGE(PG8_SB(0, 1), b2 + hstep, voffB); PG8_STAGEA(PG8_SA(0, 0), a2);
            PG8_WAIT_LOOP; PG8_WAIT_L(0); PG8_BAR; PG8_MMA(1, 0, At, B0); PG8_MMA(1, 1, At, B1); PG8_BAR; PG8_SCHED;
            PG8_LDB(B0, 1, 0); PG8_LDB(B1, 1, 1); PG8_SCHED; PG8_LDA(At, 1, 0); PG8_STAGEA(PG8_SA(0, 1), a2 + hstepA);
            PG8_WAIT_LOOP; PG8_WAIT_L(0); PG8_BAR; PG8_MMA(0, 0, At, B0); PG8_MMA(0, 1, At, B1); PG8_BAR; PG8_SCHED;
            PG8_LDA(At, 1, 1); PG8_STAGE(PG8_SB(1, 0), b3, voffB); PG8_STAGE(PG8_SB(1, 1), b3 + hstep, voffB); PG8_STAGEA(PG8_SA(1, 0), a3);
            PG8_WAIT_LOOP; PG8_WAIT_L(0); PG8_BAR; PG8_MMA(1, 0, At, B0); PG8_MMA(1, 1, At, B1); PG8_BAR; PG8_SCHED;
        }
        if (wr == 0) PG8_BAR;
        E(acc, cur, wr, wc, fr, fq);
        if (!has_next) break;
#pragma unroll
        for (int a = 0; a < 2; ++a)
#pragma unroll
            for (int b = 0; b < 2; ++b)
#pragma unroll
                for (int m = 0; m < MT; ++m)
#pragma unroll
                    for (int n = 0; n < 2; ++n) acc[a][b][m][n] = (f32x4){0.f, 0.f, 0.f, 0.f};
        cur = nxt; cA = nA; cB = nB; ++ui;
        if (wr == 1) PG8_BAR;
    }
    PG8_WAIT_V(0);
    PG8_BAR;
#undef PG8_SA
#undef PG8_SB
#undef PG8_STAGE
#undef PG8_STAGEA
#undef PG8_LDA
#undef PG8_LDB
#undef PG8_MMA
#undef PG8_WAIT_V
#undef PG8_WAIT_L
#undef PG8_WAIT_LOOP
#undef PG8_BAR
#undef PG8_SCHED
}
}
using pg8::Unit;
#define ACCREF(TM) const f32x4 (&acc)[2][2][(TM) / 64][2]

typedef const Params __attribute__((address_space(4)))* KP;
__device__ __forceinline__ KP kparams() { KP kp = (KP)__builtin_amdgcn_kernarg_segment_ptr(); asm volatile("" : "+s"(kp)); return kp; }
#define KIN(i) ((const float*)kparams()->in[i])
#define KWS() ((unsigned char*)kparams()->ws)
#define KOUT() ((float*)kparams()->out)

template <int TM> struct EpiSwiglu {
    static_assert(TM == 256 || TM == 128, "128/256-row tiles never straddle a conditioning group");
    bf16_t* HID; const float* rss; const float* sW; int row_base;
    __device__ __forceinline__ void operator()(ACCREF(TM), const Unit& u, int wr, int wc, int fr, int fq) const {
        const int row0 = row_base + u.pm * TM + wr * (TM / 4) + fr, col0 = u.pn * 128 + wc * 32 + fq * 8;
        const int trow = row_base + u.pm * TM, cond = trow < TP ? 0 : 1 + ((trow - TP) >> 10);
        const float* sw = sW + (size_t)cond * 5632 + u.pn * 256 + wc * 32 + fq * 8;
        const f32x4 sg0 = *(const f32x4*)(sw), sg1 = *(const f32x4*)(sw + 4), su0 = *(const f32x4*)(sw + 128), su1 = *(const f32x4*)(sw + 132);
        float rs[2][TM / 64];
#pragma unroll
        for (int ai = 0; ai < 2; ++ai)
#pragma unroll
            for (int m = 0; m < TM / 64; ++m) rs[ai][m] = rss[row0 + ai * (TM / 2) + m * 16];
#pragma unroll
        for (int ai = 0; ai < 2; ++ai)
#pragma unroll
            for (int m = 0; m < TM / 64; ++m) {
                const float r = rsqrtf(rs[ai][m] * (1.f / 1024.f) + 1e-6f);
                const f32x4 g0 = acc[ai][0][m][0] * r + sg0, g1 = acc[ai][0][m][1] * r + sg1, u0 = acc[ai][1][m][0] * r + su0, u1 = acc[ai][1][m][1] * r + su1;
                u32x4 w;
                w.x = cvt_pk_bf16(siluf_(g0[0]) * u0[0], siluf_(g0[1]) * u0[1]); w.y = cvt_pk_bf16(siluf_(g0[2]) * u0[2], siluf_(g0[3]) * u0[3]);
                w.z = cvt_pk_bf16(siluf_(g1[0]) * u1[0], siluf_(g1[1]) * u1[1]); w.w = cvt_pk_bf16(siluf_(g1[2]) * u1[2], siluf_(g1[3]) * u1[3]);
                *(u32x4*)(HID + (size_t)(row0 + ai * (TM / 2) + m * 16) * FFN + col0) = w;
            }
    }
};

template <int TM> struct EpiResid {
    int layer, sub;
    __device__ __forceinline__ void operator()(ACCREF(TM), const Unit& u, int wr, int wc, int fr, int fq) const {
        constexpr int MT = TM / 64;
        unsigned char* ws = KWS();
        const int sidx = layer * 3 + sub;
        const bool first = (sidx == 0), lastsub = (sidx == 11);
        float* X = (float*)(ws + WS_X);
        const float* xin_p = first ? KIN(0) : X; const float* xin_s = first ? KIN(1) : X + (size_t)TP * D;
        float* xout = lastsub ? KOUT() : X;
        const float* gate = (const float*)(ws + WS_MOD) + (size_t)layer * 5 * 9216 + (3 * sub + 2) * 1024;
        const float coef = (sub == 1) ? 1.f : 0.5f;
        const bool has_next = !lastsub;
        const float* gsn = (const float*)(ws + WS_GS) + (size_t)(sidx + 1) * 5 * 1024; float* rssn = (float*)(ws + WS_RSS) + (size_t)(sidx + 1) * T; bf16_t* XS = (bf16_t*)(ws + WS_H);
        const int row0 = u.pm * TM + wr * (TM / 4) + fr, col0 = u.pn * 256 + wc * 32 + fq * 8;
        const int tr0 = u.pm * TM, c_lo = tr0 < TP ? 0 : 1 + ((tr0 - TP) >> 10), c_hi = (tr0 + TM - 1) < TP ? 0 : 1 + ((tr0 + TM - 1 - TP) >> 10);
        const bool cuni = (c_lo == c_hi);
        f32x4 gvu[2][2], qu[2][2];
#pragma unroll
        for (int bj = 0; bj < 2; ++bj)
#pragma unroll
            for (int n = 0; n < 2; ++n) { gvu[bj][n] = *(const f32x4*)(gate + (size_t)c_lo * 9216 + col0 + bj * 128 + 4 * n); qu[bj][n] = *(const f32x4*)(gsn + (size_t)c_lo * 1024 + col0 + bj * 128 + 4 * n); }
#pragma unroll
        for (int ai = 0; ai < 2; ++ai) {
            f32x4 xv[MT][2][2];
#pragma unroll
            for (int m = 0; m < MT; ++m) {
                const int row = row0 + ai * (TM / 2) + m * 16;
                const int cond = row < TP ? 0 : 1 + ((row - TP) >> 10);
                const float* xi = ((row < TP) ? xin_p : (xin_s - (size_t)TP * D)) + (size_t)row * D + col0;
#pragma unroll
                for (int bj = 0; bj < 2; ++bj)
#pragma unroll
                    for (int n = 0; n < 2; ++n) xv[m][bj][n] = *(const f32x4*)(xi + bj * 128 + 4 * n);
            }
#pragma unroll
            for (int m = 0; m < MT; ++m) {
                const int row = row0 + ai * (TM / 2) + m * 16;
                const int cond = row < TP ? 0 : 1 + ((row - TP) >> 10);
                const size_t ro = (size_t)row * D + col0;
                f32x4 xn[2][2];
#pragma unroll
                for (int bj = 0; bj < 2; ++bj)
#pragma unroll
                    for (int n = 0; n < 2; ++n) xn[bj][n] = xv[m][bj][n] + (cuni ? gvu[bj][n] : *(const f32x4*)(gate + (size_t)cond * 9216 + col0 + bj * 128 + 4 * n)) * coef * acc[ai][bj][m][n];
                if (has_next) {
                    const float* gq = gsn + (size_t)cond * 1024 + col0;
                    const f32x4 q00 = cuni ? qu[0][0] : *(const f32x4*)(gq), q01 = cuni ? qu[0][1] : *(const f32x4*)(gq + 4), q10 = cuni ? qu[1][0] : *(const f32x4*)(gq + 128), q11 = cuni ? qu[1][1] : *(const f32x4*)(gq + 132);
                    float ss = 0.f;
#pragma unroll
                    for (int bj = 0; bj < 2; ++bj) {
                        const f32x4 a = xn[bj][0], c = xn[bj][1];
                        ss += a[0] * a[0] + a[1] * a[1] + a[2] * a[2] + a[3] * a[3] + c[0] * c[0] + c[1] * c[1] + c[2] * c[2] + c[3] * c[3];
                        const f32x4 sa = a * (bj ? q10 : q00), sc = c * (bj ? q11 : q01);
                        u32x4 w; w.x = cvt_pk_bf16(sa[0], sa[1]); w.y = cvt_pk_bf16(sa[2], sa[3]); w.z = cvt_pk_bf16(sc[0], sc[1]); w.w = cvt_pk_bf16(sc[2], sc[3]);
                        *(u32x4*)(XS + ro + bj * 128) = w;
                    }
                    ss += __shfl_xor(ss, 16); ss += __shfl_xor(ss, 32);
                    if (fq == 0) (void)__hip_atomic_fetch_add(rssn + row, ss, __ATOMIC_RELAXED, __HIP_MEMORY_SCOPE_AGENT);
                }
#pragma unroll
                for (int bj = 0; bj < 2; ++bj)
#pragma unroll
                    for (int n = 0; n < 2; ++n) *(f32x4*)(xout + ro + bj * 128 + 4 * n) = xn[bj][n];
            }
        }
    }
};

template <int TM> struct EpiEvenIn {
    int j, s;
    __device__ __forceinline__ void operator()(ACCREF(TM), const Unit& u, int wr, int wc, int fr, int fq) const {
        constexpr int MT = TM / 64;
        const int pn = u.pn, rowb = u.pm * TM + wr * (TM / 4) + fr;
        unsigned char* ws = KWS();
        const float* rss = (const float*)(ws + WS_RSS) + (size_t)s * T;
        const float* sWb = (const float*)(ws + WS_SW) + SW_EI + (size_t)j * 5 * 1792 + pn * 256 + wc * 32 + fq * 8;
        const int tr0 = u.pm * TM, c_lo = tr0 < TP ? 0 : 1 + ((tr0 - TP) >> 10), c_hi = (tr0 + TM - 1) < TP ? 0 : 1 + ((tr0 + TM - 1 - TP) >> 10);
        const bool cuni = (c_lo == c_hi);
        f32x4 su[2][2];
#pragma unroll
        for (int bj = 0; bj < 2; ++bj)
#pragma unroll
            for (int n = 0; n < 2; ++n) su[bj][n] = *(const f32x4*)(sWb + (size_t)c_lo * 1792 + 128 * bj + 4 * n);
        float rsv[2][MT];
#pragma unroll
        for (int ai = 0; ai < 2; ++ai)
#pragma unroll
            for (int m = 0; m < MT; ++m) rsv[ai][m] = rsqrtf(rss[rowb + ai * (TM / 2) + m * 16] * (1.f / 1024.f) + 1e-6f);
        if (pn >= 3) {
            float* glu = (float*)(ws + WS_GLU);
#pragma unroll
            for (int ai = 0; ai < 2; ++ai)
#pragma unroll
                for (int m = 0; m < MT; ++m) {
                    const int row = rowb + ai * (TM / 2) + m * 16;
                    const float rs = rsv[ai][m];
                    const float* sw = sWb + (size_t)(row < TP ? 0 : 1 + ((row - TP) >> 10)) * 1792;
                    float* o = glu + (size_t)row * 512 + (pn - 3) * 128 + wc * 32 + fq * 8;
#pragma unroll
                    for (int n = 0; n < 2; ++n) {
                        const f32x4 a = acc[ai][0][m][n] * rs + (cuni ? su[0][n] : *(const f32x4*)(sw + 4 * n)), b = acc[ai][1][m][n] * rs + (cuni ? su[1][n] : *(const f32x4*)(sw + 128 + 4 * n));
                        f32x4 r; r[0] = a[0] * sigmoidf_(b[0]); r[1] = a[1] * sigmoidf_(b[1]); r[2] = a[2] * sigmoidf_(b[2]); r[3] = a[3] * sigmoidf_(b[3]);
                        *(f32x4*)(o + 4 * n) = r;
                    }
                }
            return;
        }
        const bool isq = pn < 2, isv = (!isq) && (wc >= 2);
        const int head = isq ? pn * 4 + wc : (wc & 1);
        const float* gam = (isq ? KIN(13) : KIN(14)) + j * 64 + 8 * fq;
        f32x4 gmv[2][2];
#pragma unroll
        for (int bj = 0; bj < 2; ++bj)
#pragma unroll
            for (int n = 0; n < 2; ++n) gmv[bj][n] = *(const f32x4*)(gam + 32 * bj + 4 * n);
        const float* ropec = (const float*)(ws + WS_ROPE) + 4 * fq;
        float* ncb = KOUT() + (size_t)T * D + (isv ? (size_t)32 * 2 * 256 * 128 : 0) + (size_t)j * 256 * 128 + head * 64 + 8 * fq;
#pragma unroll 1
        for (int am = 0; am < 2 * MT; ++am) {
            const int ai = am / MT, m = am % MT;
            const int row = rowb + ai * (TM / 2) + m * 16;
            const bool samp = row >= TP;
            f32x4 v[2][2];
#pragma unroll
            for (int a2 = 0; a2 < 2; ++a2)
#pragma unroll
                for (int m2 = 0; m2 < MT; ++m2)
                    if (a2 == ai && m2 == m) {
#pragma unroll
                        for (int bj = 0; bj < 2; ++bj)
#pragma unroll
                            for (int n = 0; n < 2; ++n) v[bj][n] = acc[a2][bj][m2][n];
                    }
            {
                float rs0 = 0.f;
#pragma unroll
                for (int a2 = 0; a2 < 2; ++a2)
#pragma unroll
                    for (int m2 = 0; m2 < MT; ++m2) rs0 = (a2 == ai && m2 == m) ? rsv[a2][m2] : rs0;
                const float* sw = sWb + (size_t)(row < TP ? 0 : 1 + ((row - TP) >> 10)) * 1792;
#pragma unroll
                for (int bj = 0; bj < 2; ++bj)
#pragma unroll
                    for (int n = 0; n < 2; ++n) v[bj][n] = v[bj][n] * rs0 + (cuni ? su[bj][n] : *(const f32x4*)(sw + 128 * bj + 4 * n));
            }
            if (!isv) {
                float ss = 0.f;
#pragma unroll
                for (int bj = 0; bj < 2; ++bj)
#pragma unroll
                    for (int n = 0; n < 2; ++n) ss += v[bj][n][0] * v[bj][n][0] + v[bj][n][1] * v[bj][n][1] + v[bj][n][2] * v[bj][n][2] + v[bj][n][3] * v[bj][n][3];
                ss += __shfl_xor(ss, 16); ss += __shfl_xor(ss, 32);
                const float rs = rsqrtf(ss * (1.f / 64.f) + 1e-6f);
#pragma unroll
                for (int bj = 0; bj < 2; ++bj)
#pragma unroll
                    for (int n = 0; n < 2; ++n) v[bj][n] = v[bj][n] * gmv[bj][n] * rs;
            }
            int b, l;
            if (samp) { const int tl = row - TP; b = tl >> 10; l = tl & 1023; } else { b = row >> 8; l = row & 255; }
            if (samp && !isv) {
#pragma unroll
                for (int bj = 0; bj < 2; ++bj) {
                    const f32x4 c4 = *(const f32x4*)(ropec + l * 32 + 16 * bj), s4 = *(const f32x4*)(ropec + 32768 + l * 32 + 16 * bj);
                    f32x4 a = v[bj][0], r;
                    r[0] = a[0] * c4[0] - a[1] * s4[0]; r[1] = a[0] * s4[0] + a[1] * c4[0]; r[2] = a[2] * c4[1] - a[3] * s4[1]; r[3] = a[2] * s4[1] + a[3] * c4[1];
                    v[bj][0] = r; a = v[bj][1];
                    r[0] = a[0] * c4[2] - a[1] * s4[2]; r[1] = a[0] * s4[2] + a[1] * c4[2]; r[2] = a[2] * c4[3] - a[3] * s4[3]; r[3] = a[2] * s4[3] + a[3] * c4[3];
                    v[bj][1] = r;
                }
            }
            if (!samp && !isq) {
                float* nc = ncb + ((size_t)(b * 2) * 256 + l) * 128;
#pragma unroll
                for (int bj = 0; bj < 2; ++bj) { *(f32x4*)(nc + 32 * bj) = v[bj][0]; *(f32x4*)(nc + 32 * bj + 4) = v[bj][1]; }
            }
            if (!isv) {
                const float sc = isq ? C2 : 1.f;
                bf16_t* dst;
                if (isq) dst = (bf16_t*)(ws + WS_Q) + (size_t)row * 512 + head * 64;
                else if (samp) dst = (bf16_t*)(ws + WS_KS) + (size_t)j * 4 * 2 * 1536 * 64 + ((size_t)(b * 2 + head) * 1536 + 512 + l) * 64;
                else dst = (bf16_t*)(ws + WS_KP) + ((size_t)(b * 2 + head) * 256 + l) * 64;
#pragma unroll
                for (int bj = 0; bj < 2; ++bj) { const f32x4 a = v[bj][0] * sc, c = v[bj][1] * sc; u32x4 w; w.x = cvt_pk_bf16(a[0], a[1]); w.y = cvt_pk_bf16(a[2], a[3]); w.z = cvt_pk_bf16(c[0], c[1]); w.w = cvt_pk_bf16(c[2], c[3]);
                    *(u32x4*)(dst + 32 * bj + 8 * fq) = w; }
            } else {
                bf16_t* vt; size_t vp;
                if (samp) { vt = (bf16_t*)(ws + WS_VST) + (size_t)j * 4 * 2 * 64 * 1536 + (size_t)(b * 2 + head) * 64 * 1536 + 512 + l; vp = 1536; }
                else { vt = (bf16_t*)(ws + WS_VPT) + (size_t)(b * 2 + head) * 64 * 256 + l; vp = 256; }
#pragma unroll
                for (int bj = 0; bj < 2; ++bj)
#pragma unroll
                    for (int n = 0; n < 2; ++n)
#pragma unroll
                        for (int jj = 0; jj < 4; ++jj) vt[(size_t)(32 * bj + 8 * fq + 4 * n + jj) * vp] = f2bf(v[bj][n][jj]);
            }
        }
    }
};

template <int TM> struct EpiOddIn {
    bf16_t* FTp; bf16_t* FTs; bf16_t* U; float* V; const float* rss; const float* sW;
    __device__ __forceinline__ void operator()(ACCREF(TM), const Unit& u, int wr, int wc, int fr, int fq) const {
        const int pn = u.pn, rowb = u.pm * TM + wr * (TM / 4) + fr;
        constexpr int MT = TM / 64;
        const int tr0 = u.pm * TM, c_lo = tr0 < TP ? 0 : 1 + ((tr0 - TP) >> 10), c_hi = (tr0 + TM - 1) < TP ? 0 : 1 + ((tr0 + TM - 1 - TP) >> 10);
        const float* swb = sW + pn * 256 + wc * 32 + fq * 8;
        f32x4 su[2][2];
#pragma unroll
        for (int bj = 0; bj < 2; ++bj)
#pragma unroll
            for (int n = 0; n < 2; ++n) su[bj][n] = *(const f32x4*)(swb + (size_t)c_lo * 2048 + 128 * bj + 4 * n);
        float rsv[2][MT];
#pragma unroll
        for (int ai = 0; ai < 2; ++ai)
#pragma unroll
            for (int m = 0; m < MT; ++m) rsv[ai][m] = rss[rowb + ai * (TM / 2) + m * 16];
#pragma unroll
        for (int ai = 0; ai < 2; ++ai)
#pragma unroll
            for (int m = 0; m < MT; ++m) {
                const int row = rowb + ai * (TM / 2) + m * 16;
                const float rs = rsqrtf(rsv[ai][m] * (1.f / 1024.f) + 1e-6f);
                f32x4 vv[2][2];
                if (c_lo == c_hi) {
#pragma unroll
                    for (int bj = 0; bj < 2; ++bj)
#pragma unroll
                        for (int n = 0; n < 2; ++n) vv[bj][n] = acc[ai][bj][m][n] * rs + su[bj][n];
                } else {
                    const float* sw = swb + (size_t)(row < TP ? 0 : 1 + ((row - TP) >> 10)) * 2048;
#pragma unroll
                    for (int bj = 0; bj < 2; ++bj)
#pragma unroll
                        for (int n = 0; n < 2; ++n) vv[bj][n] = acc[ai][bj][m][n] * rs + *(const f32x4*)(sw + 128 * bj + 4 * n);
                }
                if (pn < 4) {
                    const int isS = pn >> 1;
                    bf16_t* dst; size_t pitch;
                    if (row < TP) { const int b = row >> 8, l = row & 255; dst = FTp + (size_t)b * 512 * 512 + isS * 256 + l; pitch = 512; }
                    else { const int tl = row - TP, b = tl >> 10, l = tl & 1023; dst = FTs + (size_t)b * 512 * 2048 + isS * 1024 + l; pitch = 2048; }
#pragma unroll
                    for (int bj = 0; bj < 2; ++bj)
#pragma unroll
                        for (int n = 0; n < 2; ++n)
#pragma unroll
                            for (int j = 0; j < 4; ++j) { const int nf = (pn & 1) * 256 + 128 * bj + 32 * wc + 8 * fq + 4 * n + j; dst[(size_t)nf * pitch] = f2bf(vv[bj][n][j]); }
                } else if (pn < 6) {
#pragma unroll
                    for (int bj = 0; bj < 2; ++bj) { const f32x4 a = vv[bj][0], c = vv[bj][1]; u32x4 w; w.x = cvt_pk_bf16(a[0], a[1]); w.y = cvt_pk_bf16(a[2], a[3]); w.z = cvt_pk_bf16(c[0], c[1]); w.w = cvt_pk_bf16(c[2], c[3]);
                        *(u32x4*)(U + (size_t)row * 512 + (pn - 4) * 256 + 128 * bj + 32 * wc + 8 * fq) = w; }
                } else {
#pragma unroll
                    for (int bj = 0; bj < 2; ++bj)
#pragma unroll
                        for (int n = 0; n < 2; ++n) *(f32x4*)(V + (size_t)row * 512 + (pn - 6) * 256 + 128 * bj + 32 * wc + 8 * fq + 4 * n) = vv[bj][n];
                }
            }
    }
};

struct EpiFourier {
    bf16_t* MIX; int tok0, L;
    __device__ __forceinline__ void operator()(ACCREF(256), const Unit& u, int wr, int wc, int fr, int fq) const {
        const int b = u.pn >> 1, nb = (u.pn & 1) * 256 + 32 * wc + 8 * fq;
#pragma unroll
        for (int ai = 0; ai < 2; ++ai)
#pragma unroll
            for (int m = 0; m < 4; ++m) {
                const int lp = u.pm * 256 + wr * 64 + fr + ai * 128 + m * 16;
#pragma unroll
                for (int bj = 0; bj < 2; ++bj) { const f32x4 a = acc[ai][bj][m][0], c = acc[ai][bj][m][1]; u32x4 w; w.x = cvt_pk_bf16(a[0], a[1]); w.y = cvt_pk_bf16(a[2], a[3]); w.z = cvt_pk_bf16(c[0], c[1]); w.w = cvt_pk_bf16(c[2], c[3]);
                    *(u32x4*)(MIX + (size_t)(tok0 + b * L + lp) * D + nb + 128 * bj) = w; }
            }
    }
};

#define XB_TMO      128
#define XB_XCNT(j)  (256  + 64 * (j))
#define XB_XSUB(j)  (1280 + 64 * (j))
#define XB_XGEN(j)  (2304 + 64 * (j))
#define XB_TOP      3328
#define XB_TOPGEN   3392
#define XCD_BAR_WORDS 3456
#define XB_SPIN_CAP (1u << 20)
__device__ __forceinline__ unsigned xb_ld(unsigned* p)              { return __hip_atomic_load(p, __ATOMIC_RELAXED, __HIP_MEMORY_SCOPE_AGENT); }
__device__ __forceinline__ unsigned xb_add(unsigned* p, unsigned v) { return __hip_atomic_fetch_add(p, v, __ATOMIC_RELAXED, __HIP_MEMORY_SCOPE_AGENT); }
__device__ __forceinline__ unsigned xb_xcc_id() { return (unsigned)__builtin_amdgcn_s_getreg((3 << 11) | 20) & 0xFu; }
#define XB_SPIN(cond, bar) do { unsigned _sp = 0; while (cond) { __builtin_amdgcn_s_sleep(1); \
    if ((++_sp & 255u) == 0u) { if (xb_ld(&(bar)[XB_TMO])) break; if (_sp > XB_SPIN_CAP) { atomicAdd(&(bar)[XB_TMO], 1u); break; } } } } while (0)
__device__ __forceinline__ void xcd_barrier_complete(unsigned* bar, unsigned x, unsigned& nloc, unsigned& nx) {
    const unsigned G = gridDim.x;
    unsigned sum, cnt, mine, sp = 0u;
    for (;;) {
        sum = 0u; cnt = 0u; mine = 0u;
#pragma unroll
        for (unsigned j = 0; j < 16; ++j) { const unsigned c = xb_ld(&bar[XB_XCNT(j)]); sum += c; cnt += (c > 0u) ? 1u : 0u; mine = (j == x) ? c : mine; }
        if (sum == G) break;
        __builtin_amdgcn_s_sleep(1);
        if ((++sp & 255u) == 0u) { if (xb_ld(&bar[XB_TMO])) break; if (sp > XB_SPIN_CAP) { atomicAdd(&bar[XB_TMO], 1u); break; } }
    }
    nloc = mine > 0u ? mine : 1u; nx = cnt > 0u ? cnt : 1u;
}
__device__ __noinline__ void xcd_barrier(unsigned* bar, volatile LAS unsigned* st) {
    asm volatile("s_waitcnt vmcnt(0)" ::: "memory");
    __syncthreads();
    if (threadIdx.x == 0) {
        const unsigned x = xb_xcc_id();
        __builtin_amdgcn_s_waitcnt(0);
        unsigned nloc = st[0], nx = st[1];
        if (nloc == 0u) { xcd_barrier_complete(bar, x, nloc, nx); st[0] = nloc; st[1] = nx; }
        const unsigned old = xb_add(&bar[XB_XSUB(x)], 1u);
        const unsigned gen = old / nloc;
        if (old + 1u == (gen + 1u) * nloc) {
            __builtin_amdgcn_fence(__ATOMIC_RELEASE, "agent");
            asm volatile("s_waitcnt vmcnt(0)" ::: "memory");
            const unsigned og = xb_add(&bar[XB_TOP], 1u);
            const unsigned tg = og / nx;
            if (og + 1u == (tg + 1u) * nx) xb_add(&bar[XB_TOPGEN], 1u);
            else XB_SPIN(xb_ld(&bar[XB_TOPGEN]) == tg, bar);
            __builtin_amdgcn_fence(__ATOMIC_ACQUIRE, "agent");
            xb_add(&bar[XB_XGEN(x)], 1u);
            asm volatile("s_waitcnt vmcnt(0)" ::: "memory");
        } else {
            __builtin_amdgcn_fence(__ATOMIC_ACQUIRE, "agent");
            XB_SPIN(xb_ld(&bar[XB_XGEN(x)]) == gen, bar);
            asm volatile("s_waitcnt vmcnt(0)" ::: "memory");
        }
    }
    __syncthreads();
}

struct TrItem { const float* src; bf16_t* dst; int Nsrc, K; };
__device__ __forceinline__ TrItem tr_decode(const Params* kp, int it) {
    constexpr int I_F1 = 8 * 16 * 176, I_F2 = 8 * 44 * 32, I_EI = 2 * 16 * 56, I_EO = 2 * 16 * 32, I_OI = 2 * 16 * 32;
    unsigned char* ws = kp->ws;
    TrItem t; int r = it;
    if (r < I_F1) { const int mat = r / (16 * 176), rr = r % (16 * 176), kb = rr / 176, n0 = (rr % 176) * 32;
        const int pn = n0 >> 8, bj = (n0 >> 7) & 1, q = n0 & 127, src = bj * FFN + pn * 128 + q;
        t.Nsrc = 5632; t.K = D; t.src = kp->in[9] + (size_t)mat * D * 5632 + (size_t)(kb * 64) * 5632 + src; t.dst = (bf16_t*)(ws + WS_WF1) + ((size_t)mat * 5632 + n0) * D + kb * 64; return t; }
    r -= I_F1;
    if (r < I_F2) { const int mat = r / (44 * 32), rr = r % (44 * 32), kb = rr / 32, n0 = (rr % 32) * 32;
        t.Nsrc = D; t.K = FFN; t.src = kp->in[10] + (size_t)mat * FFN * D + (size_t)(kb * 64) * D + n0; t.dst = (bf16_t*)(ws + WS_WF2) + ((size_t)mat * D + n0) * FFN + kb * 64; return t; }
    r -= I_F2;
    if (r < I_EI) { const int mat = r / (16 * 56), rr = r % (16 * 56), kb = rr / 56, n0 = (rr % 56) * 32;
        const int pn = n0 >> 8, bj = (n0 >> 7) & 1, wc = (n0 >> 5) & 3; int src;
        if (pn < 2) src = (pn * 4 + wc) * 64 + 32 * bj;
        else if (pn == 2) src = (wc < 2 ? 512 + wc * 64 : 640 + (wc - 2) * 64) + 32 * bj;
        else src = 768 + bj * 512 + (pn - 3) * 128 + 32 * wc;
        t.Nsrc = 1792; t.K = D; t.src = kp->in[11] + (size_t)mat * D * 1792 + (size_t)(kb * 64) * 1792 + src; t.dst = (bf16_t*)(ws + WS_WEI) + ((size_t)mat * 1792 + n0) * D + kb * 64; return t; }
    r -= I_EI;
    if (r < I_EO) { const int mat = r / (16 * 32), rr = r % (16 * 32), kb = rr / 32, n0 = (rr % 32) * 32;
        t.Nsrc = D; t.K = D; t.src = kp->in[12] + (size_t)mat * D * D + (size_t)(kb * 64) * D + n0; t.dst = (bf16_t*)(ws + WS_WEO) + ((size_t)mat * D + n0) * D + kb * 64; return t; }
    r -= I_EO;
    if (r < I_OI) { const int mat = r / (16 * 32), rr = r % (16 * 32), kb = rr / 32, n0 = (rr % 32) * 32;
        t.Nsrc = 1536; t.K = D; t.src = kp->in[19] + (size_t)mat * D * 1536 + (size_t)(kb * 64) * 1536 + 512 + n0; t.dst = (bf16_t*)(ws + WS_WOI) + ((size_t)mat * 2048 + 1024 + n0) * D + kb * 64; return t; }
    r -= I_OI;
    { const int mat = r / (16 * 32), rr = r % (16 * 32), kb = rr / 32, n0 = (rr % 32) * 32;
        t.Nsrc = D; t.K = D; t.src = kp->in[20] + (size_t)mat * D * D + (size_t)(kb * 64) * D + n0; t.dst = (bf16_t*)(ws + WS_WOO) + ((size_t)mat * D + n0) * D + kb * 64; return t; }
}
__device__ __noinline__ void pro_a(const Params* kp, unsigned char* lds, int G) {
    const int tid = threadIdx.x, lane = tid & 63, wave = tid >> 6;
    float* scr = (float*)(lds + wave * 8704);
    const int gw = blockIdx.x * 8 + wave, NGW = G * 8;
    constexpr int TOT = 8 * 16 * 176 + 8 * 44 * 32 + 2 * 16 * 56 + 3 * 2 * 16 * 32;
    if (gw >= TOT) return;
    const int lr = lane >> 5, lc = lane & 31;
    TrItem cur = tr_decode(kp, gw);
    float r[32];
#pragma unroll
    for (int i = 0; i < 32; ++i) r[i] = cur.src[(size_t)(2 * i + lr) * cur.Nsrc + lc];
    for (int it = gw; it < TOT; it += NGW) {
        const bool has_next = it + NGW < TOT;
        TrItem nxt = cur; if (has_next) nxt = tr_decode(kp, it + NGW);
#pragma unroll
        for (int i = 0; i < 32; ++i) scr[(2 * i + lr) * 33 + lc] = r[i];
        __builtin_amdgcn_fence(__ATOMIC_RELEASE, "wavefront"); __builtin_amdgcn_wave_barrier();
        if (has_next) {
#pragma unroll
            for (int i = 0; i < 32; ++i) r[i] = nxt.src[(size_t)(2 * i + lr) * nxt.Nsrc + lc];
        }
        const int c = lane & 7;
#pragma unroll
        for (int j = 0; j < 4; ++j) { const int n = (lane >> 3) + 8 * j; const float* sp = scr + (8 * c) * 33 + n;
            u32x4 o; o.x = cvt_pk_bf16(sp[0 * 33], sp[1 * 33]); o.y = cvt_pk_bf16(sp[2 * 33], sp[3 * 33]); o.z = cvt_pk_bf16(sp[4 * 33], sp[5 * 33]); o.w = cvt_pk_bf16(sp[6 * 33], sp[7 * 33]);
            *(u32x4*)(cur.dst + (size_t)n * cur.K + 8 * c) = o; }
        __builtin_amdgcn_fence(__ATOMIC_RELEASE, "wavefront"); __builtin_amdgcn_wave_barrier();
        cur = nxt;
    }
}
__device__ __noinline__ void pro_b(const Params* kp, unsigned char* lds, int G) {
    const int tid = threadIdx.x, lane = tid & 63, wave = tid >> 6;
    unsigned char* ws = kp->ws;
    {
        float* Wt = (float*)lds;
        float* cs = Wt + 32 * 132; float* sn = cs + 128;
        if (tid < 128) { float sv, cv; sincospif((float)tid * (1.f / 64.f), &sv, &cv); cs[tid] = cv * 0.08838834764831845f; sn[tid] = sv * 0.08838834764831845f; }
        for (int item = blockIdx.x; item < 256; item += G) {
            const int j = item >> 7, g = (item >> 5) & 3, k0 = (item & 31) * 32;
            const float* W = kp->in[19] + (size_t)j * D * 1536;
            for (int e = tid; e < 32 * 128; e += 512) { const int kk = e >> 7, c = e & 127; Wt[kk * 132 + c] = W[(size_t)(k0 + kk) * 1536 + g * 128 + c]; }
            __syncthreads();
            const int cp = tid & 127, kg = tid >> 7;
            float aC[8], aS[8];
#pragma unroll
            for (int i = 0; i < 8; ++i) { aC[i] = 0.f; aS[i] = 0.f; }
            for (int c = 0; c < 128; c += 4) {
                float cv[4], sv[4];
#pragma unroll
                for (int q = 0; q < 4; ++q) { const int idx = ((c + q) * cp) & 127; cv[q] = cs[idx]; sv[q] = sn[idx]; }
#pragma unroll
                for (int i = 0; i < 8; ++i) { const f32x4 w = *(const f32x4*)(Wt + (kg * 8 + i) * 132 + c);
                    aC[i] += w[0] * cv[0] + w[1] * cv[1] + w[2] * cv[2] + w[3] * cv[3]; aS[i] += w[0] * sv[0] + w[1] * sv[1] + w[2] * sv[2] + w[3] * sv[3]; }
            }
            bf16_t* oc = (bf16_t*)(ws + WS_WOI) + ((size_t)j * 2048 + g * 128 + cp) * D + k0 + kg * 8;
            bf16_t* os = oc + (size_t)512 * D;
            u32x4 w;
            w.x = cvt_pk_bf16(aC[0], aC[1]); w.y = cvt_pk_bf16(aC[2], aC[3]); w.z = cvt_pk_bf16(aC[4], aC[5]); w.w = cvt_pk_bf16(aC[6], aC[7]); *(u32x4*)oc = w;
            w.x = cvt_pk_bf16(aS[0], aS[1]); w.y = cvt_pk_bf16(aS[2], aS[3]); w.z = cvt_pk_bf16(aS[4], aS[5]); w.w = cvt_pk_bf16(aS[6], aS[7]); *(u32x4*)os = w;
            __syncthreads();
        }
    }
    (void)lane; (void)wave; (void)ws;
}
__device__ __noinline__ void pro_c(const Params* kp, unsigned char* lds, int G) {
    const int tid = threadIdx.x, lane = tid & 63, wave = tid >> 6;
    unsigned char* ws = kp->ws;
    {
        const int gt = blockIdx.x * 512 + tid, NGT = G * 512;
        for (int it = gt; it < (256 * 512 + 1024 * 2048) / 8; it += NGT) {
            int e = it * 8; int L; bf16_t* dst;
            if (e < 256 * 512) { L = 256; dst = (bf16_t*)(ws + WS_D256); } else { e -= 256 * 512; L = 1024; dst = (bf16_t*)(ws + WS_D1024); }
            const int lp = e / (2 * L), cc = e % (2 * L), isS = cc >= L, l0 = cc - (isS ? L : 0);
            const float nrm = (L == 256) ? 0.0625f : 0.03125f;
            float v[8];
#pragma unroll
            for (int i = 0; i < 8; ++i) { const int mm = ((l0 + i) * lp) & (L - 1); float s, c; sincospif(2.f * (float)mm / (float)L, &s, &c); v[i] = isS ? -s * nrm : c * nrm; }
            u32x4 w; w.x = cvt_pk_bf16(v[0], v[1]); w.y = cvt_pk_bf16(v[2], v[3]); w.z = cvt_pk_bf16(v[4], v[5]); w.w = cvt_pk_bf16(v[6], v[7]);
            *(u32x4*)(dst + e) = w;
        }
        for (int it = gt; it < 12 * T; it += NGT) ((float*)(ws + WS_RSS))[it] = 0.f;
        for (int it = gt; it < 1024 * 32; it += NGT) {
            const int l = it >> 5, i = it & 31, f = i & 15;
            const float pos = (float)((i < 16) ? (l >> 6) : (l & 63));
            const float invf = 1.0f / powf(10000.f, (float)(2 * f) / 32.f);
            const float ang = pos * invf;
            ((float*)(ws + WS_ROPE))[it] = cosf(ang); ((float*)(ws + WS_ROPE))[32768 + it] = sinf(ang);
        }
        for (int it = gt; it < 4 * 2 * 512 * 128; it += NGT) {
            const int d = it & 63, kvh = (it >> 6) & 1, s = (it >> 7) & 511, j = (it >> 16) & 1, b = it >> 17;
            ((bf16_t*)(ws + WS_KS))[((size_t)((j * 4 + b) * 2 + kvh) * 1536 + s) * 64 + d] = f2bf(kp->in[2][it]);
            ((bf16_t*)(ws + WS_VST))[((size_t)((j * 4 + b) * 2 + kvh) * 64 + d) * 1536 + s] = f2bf(kp->in[3][it]);
        }
    }
    (void)lane; (void)wave; (void)ws;
}
__device__ __noinline__ void pro_d(const Params* kp, unsigned char* lds, int G) {
    const int tid = threadIdx.x;
    unsigned char* ws = kp->ws;
    float* sl = (float*)lds;
    float* red = sl + 5 * 1024;
    for (int e = tid; e < 5 * 1024; e += 512) { const int c = e >> 10, k = e & 1023; const float x = (c == 0) ? kp->in[5][k] : kp->in[4][(c - 1) * 1024 + k]; sl[e] = siluf_(x); }
    __syncthreads();
    for (int item = blockIdx.x; item < 4 * 144; item += G) {
        const int layer = item / 144, c0 = (item % 144) * 64;
        const int cl = tid & 63, kq = tid >> 6;
        const float* W = kp->in[6] + (size_t)layer * D * 9216 + (size_t)(kq * 128) * 9216 + c0 + cl;
        const float* s0 = sl + kq * 128;
        float a0 = 0.f, a1 = 0.f, a2 = 0.f, a3 = 0.f, a4 = 0.f;
#pragma unroll 1
        for (int kb = 0; kb < 128; kb += 32) {
            float w[32];
#pragma unroll
            for (int i = 0; i < 32; ++i) w[i] = W[(size_t)(kb + i) * 9216];
#pragma unroll
            for (int i = 0; i < 32; ++i) { const int k = kb + i; a0 += s0[k] * w[i]; a1 += s0[1024 + k] * w[i]; a2 += s0[2048 + k] * w[i]; a3 += s0[3072 + k] * w[i]; a4 += s0[4096 + k] * w[i]; }
        }
        red[(kq * 5 + 0) * 64 + cl] = a0; red[(kq * 5 + 1) * 64 + cl] = a1; red[(kq * 5 + 2) * 64 + cl] = a2; red[(kq * 5 + 3) * 64 + cl] = a3; red[(kq * 5 + 4) * 64 + cl] = a4;
        __syncthreads();
        if (tid < 5 * 64) { const int c = tid >> 6, cc = tid & 63;
            float v = kp->in[7][layer * 9216 + c0 + cc];
#pragma unroll
            for (int q = 0; q < 8; ++q) v += red[(q * 5 + c) * 64 + cc];
            ((float*)(ws + WS_MOD))[((size_t)layer * 5 + c) * 9216 + c0 + cc] = v; }
        __syncthreads();
    }
}
__device__ __forceinline__ void prologue(const Params* kp, unsigned char* lds, int G) {
    if (blockIdx.x & 1) { pro_b(kp, lds, G); __syncthreads(); pro_c(kp, lds, G); __syncthreads(); pro_d(kp, lds, G); __syncthreads(); pro_a(kp, lds, G); }
    else { pro_a(kp, lds, G); __syncthreads(); pro_b(kp, lds, G); __syncthreads(); pro_c(kp, lds, G); __syncthreads(); pro_d(kp, lds, G); }
}

__device__ __noinline__ void pre_phase(const Params* kp, int G) {
    const int tid = threadIdx.x, lane = tid & 63, gw = blockIdx.x * 8 + (tid >> 6), NGW = G * 8;
    unsigned char* ws = kp->ws;
    const float* MOD = (const float*)(ws + WS_MOD);
    for (int t = gw; t < T; t += NGW) {
        const float* xr = (t < TP) ? kp->in[0] + (size_t)t * D : kp->in[1] + (size_t)(t - TP) * D;
        const int cond = (t < TP) ? 0 : 1 + ((t - TP) >> 10);
        const float* sc = MOD + (size_t)cond * 9216 + 1024;
        f32x4 v[4]; float ss = 0.f;
#pragma unroll
        for (int j = 0; j < 4; ++j) { v[j] = *(const f32x4*)(xr + lane * 4 + 256 * j); ss += v[j][0] * v[j][0] + v[j][1] * v[j][1] + v[j][2] * v[j][2] + v[j][3] * v[j][3]; }
        ss = wave_sum(ss);
        if (lane == 0) ((float*)(ws + WS_RSS))[t] = ss;
#pragma unroll
        for (int j = 0; j < 4; ++j) {
            const int c = lane * 4 + 256 * j;
            const f32x4 o = v[j] * *(const f32x4*)(kp->in[8] + c) * (*(const f32x4*)(sc + c) + 1.f);
            u32x2 w; w.x = cvt_pk_bf16(o[0], o[1]); w.y = cvt_pk_bf16(o[2], o[3]);
            *(u32x2*)((bf16_t*)(ws + WS_H) + (size_t)t * D + c) = w;
        }
    }
    for (int e = blockIdx.x * 512 + tid; e < 12 * 5 * 1024; e += G * 512) {
        const int k = e & 1023, c = (e >> 10) % 5, sidx = e / 5120, layer = sidx / 3, sub = sidx % 3;
        ((float*)(ws + WS_GS))[e] = kp->in[8][sidx * 1024 + k] * (1.f + MOD[((size_t)layer * 5 + c) * 9216 + (3 * sub + 1) * 1024 + k]);
    }
}

__device__ __noinline__ void shiftw_phase(const Params* kp, int G) {
    const int tid = threadIdx.x, lane = tid & 63, fr = lane & 15, fq = lane >> 4, gw = blockIdx.x * 8 + (tid >> 6), NGW = G * 8;
    unsigned char* ws = kp->ws;
    const float* MOD = (const float*)(ws + WS_MOD);
    constexpr int C_F1 = 8 * 352, C_EI = 2 * 112, C_OI = 2 * 128;
    for (int ck = gw; ck < C_F1 + C_EI + C_OI; ck += NGW) {
        const bf16_t* wrow; const float* shift; float* dst; int N;
        if (ck < C_F1) { const int mat = ck / 352, n0 = (ck % 352) * 16, layer = mat >> 1, sub = (mat & 1) * 2;
            wrow = (const bf16_t*)(ws + WS_WF1) + ((size_t)mat * 5632 + n0) * D; shift = MOD + (size_t)layer * 5 * 9216 + (3 * sub) * 1024; dst = (float*)(ws + WS_SW) + (size_t)mat * 5 * 5632 + n0; N = 5632; }
        else if (ck < C_F1 + C_EI) { const int q = ck - C_F1, jj = q / 112, n0 = (q % 112) * 16;
            wrow = (const bf16_t*)(ws + WS_WEI) + ((size_t)jj * 1792 + n0) * D; shift = MOD + (size_t)(2 * jj) * 5 * 9216 + 3 * 1024; dst = (float*)(ws + WS_SW) + SW_EI + (size_t)jj * 5 * 1792 + n0; N = 1792; }
        else { const int q = ck - C_F1 - C_EI, jj = q / 128, n0 = (q % 128) * 16;
            wrow = (const bf16_t*)(ws + WS_WOI) + ((size_t)jj * 2048 + n0) * D; shift = MOD + (size_t)(2 * jj + 1) * 5 * 9216 + 3 * 1024; dst = (float*)(ws + WS_SW) + SW_OI + (size_t)jj * 5 * 2048 + n0; N = 2048; }
        const bf16_t* wp = wrow + (size_t)fr * D + fq * 8;
        const float* sp = shift + (size_t)(fr < 5 ? fr : 4) * 9216 + fq * 8;
        const float msk = fr < 5 ? 1.f : 0.f;
        f32x4 acc = (f32x4){0.f, 0.f, 0.f, 0.f};
#pragma unroll 1
        for (int kb = 0; kb < 32; kb += 4) {
            u32x4 bw[4]; f32x4 s0[4], s1[4];
#pragma unroll
            for (int i = 0; i < 4; ++i) { bw[i] = *(const u32x4*)(wp + (kb + i) * 32); s0[i] = *(const f32x4*)(sp + (kb + i) * 32); s1[i] = *(const f32x4*)(sp + (kb + i) * 32 + 4); }
#pragma unroll
            for (int i = 0; i < 4; ++i) {
                const f32x4 a0 = s0[i] * msk, a1 = s1[i] * msk;
                u32x4 aw; aw.x = cvt_pk_bf16(a0[0], a0[1]); aw.y = cvt_pk_bf16(a0[2], a0[3]); aw.z = cvt_pk_bf16(a1[0], a1[1]); aw.w = cvt_pk_bf16(a1[2], a1[3]);
                acc = __builtin_amdgcn_mfma_f32_16x16x32_bf16(__builtin_bit_cast(bf16x8, aw), __builtin_bit_cast(bf16x8, bw[i]), acc, 0, 0, 0);
            }
        }
        if (fq == 0) { dst[fr] = acc[0]; dst[(size_t)N + fr] = acc[1]; dst[(size_t)2 * N + fr] = acc[2]; dst[(size_t)3 * N + fr] = acc[3]; }
        else if (fq == 1) dst[(size_t)4 * N + fr] = acc[0];
    }
}

__device__ __noinline__ void attn_unit(const bf16_t* Q, int qrow0, int h, const bf16_t* Kb, const bf16_t* VT, int Lk, bf16_t* O, unsigned char* lds) {
    constexpr int KB = 18432, BUF = 35840, VP = 272;
    const int tid = threadIdx.x, wave = tid >> 6, lane = tid & 63, fr = lane & 15, fq = lane >> 4;
    const bf16_t* qp = Q + (size_t)(qrow0 + wave * 16 + fr) * 512 + h * 64 + fq * 8;
    const bf16x8 qf0 = *(const bf16x8*)qp, qf1 = *(const bf16x8*)(qp + 32);
    f32x4 o[4];
#pragma unroll
    for (int i = 0; i < 4; ++i) o[i] = (f32x4){0.f, 0.f, 0.f, 0.f};
    float mrun = -1e30f, lrun = 0.f;
    const int srow = tid >> 3, sch = tid & 7;
    const bf16_t* kg = Kb + srow * 64 + sch * 8;
    const bf16_t* vg = VT + (size_t)srow * Lk + sch * 8;
    const unsigned slk = srow * 144 + sch * 16, slv = KB + srow * VP + sch * 16;
    u32x4 kr0 = *(const u32x4*)kg, kr1 = *(const u32x4*)(kg + 64 * 64), vr0 = *(const u32x4*)vg, vr1 = *(const u32x4*)(vg + 64);
    *(u32x4*)(lds + slk) = kr0; *(u32x4*)(lds + slk + 64 * 144) = kr1; *(u32x4*)(lds + slv) = vr0; *(u32x4*)(lds + slv + 128) = vr1;
    __syncthreads();
    const int nt = Lk >> 7;
    for (int t = 0; t < nt; ++t) {
        const int cur = t & 1;
        if (t + 1 < nt) { const bf16_t* kn = kg + (size_t)(t + 1) * 128 * 64; const bf16_t* vn = vg + (t + 1) * 128;
            kr0 = *(const u32x4*)kn; kr1 = *(const u32x4*)(kn + 64 * 64); vr0 = *(const u32x4*)vn; vr1 = *(const u32x4*)(vn + 64); }
        const unsigned char* Kt = lds + cur * BUF; const unsigned char* Vt = Kt + KB;
        f32x4 s[8];
#pragma unroll
        for (int u = 0; u < 8; ++u) {
            const int krow = (u >> 1) * 32 + 8 * (fr >> 2) + 4 * (u & 1) + (fr & 3);
            const bf16x8 a0 = *(const bf16x8*)(Kt + krow * 144 + fq * 16), a1 = *(const bf16x8*)(Kt + krow * 144 + 64 + fq * 16);
            s[u] = __builtin_amdgcn_mfma_f32_16x16x32_bf16(a0, qf0, (f32x4){0.f, 0.f, 0.f, 0.f}, 0, 0, 0);
            s[u] = __builtin_amdgcn_mfma_f32_16x16x32_bf16(a1, qf1, s[u], 0, 0, 0);
        }
        float mx = s[0][0];
#pragma unroll
        for (int u = 0; u < 8; ++u)
#pragma unroll
            for (int j = 0; j < 4; ++j) mx = fmaxf(mx, s[u][j]);
        mx = fmaxf(mx, __shfl_xor(mx, 16)); mx = fmaxf(mx, __shfl_xor(mx, 32));
        const float mnew = fmaxf(mrun, mx), alpha = __builtin_amdgcn_exp2f(mrun - mnew); mrun = mnew;
        float ls = 0.f;
#pragma unroll
        for (int u = 0; u < 8; ++u)
#pragma unroll
            for (int j = 0; j < 4; ++j) { s[u][j] = __builtin_amdgcn_exp2f(s[u][j] - mnew); ls += s[u][j]; }
        lrun = lrun * alpha + ls;
#pragma unroll
        for (int i = 0; i < 4; ++i) o[i] = o[i] * alpha;
#pragma unroll
        for (int g2 = 0; g2 < 4; ++g2) {
            u32x4 pw; pw.x = cvt_pk_bf16(s[2 * g2][0], s[2 * g2][1]); pw.y = cvt_pk_bf16(s[2 * g2][2], s[2 * g2][3]); pw.z = cvt_pk_bf16(s[2 * g2 + 1][0], s[2 * g2 + 1][1]); pw.w = cvt_pk_bf16(s[2 * g2 + 1][2], s[2 * g2 + 1][3]);
            const bf16x8 pf = __builtin_bit_cast(bf16x8, pw);
#pragma unroll
            for (int dt = 0; dt < 4; ++dt) {
                const bf16x8 vf = *(const bf16x8*)(Vt + (dt * 16 + fr) * VP + g2 * 64 + fq * 16);
                o[dt] = __builtin_amdgcn_mfma_f32_16x16x32_bf16(vf, pf, o[dt], 0, 0, 0);
            }
        }
        if (t + 1 < nt) { unsigned char* nb = lds + (cur ^ 1) * BUF; *(u32x4*)(nb + slk) = kr0; *(u32x4*)(nb + slk + 64 * 144) = kr1; *(u32x4*)(nb + slv) = vr0; *(u32x4*)(nb + slv + 128) = vr1; }
        __syncthreads();
    }
    lrun += __shfl_xor(lrun, 16); lrun += __shfl_xor(lrun, 32);
    const float inv = 1.f / lrun;
    bf16_t* op = O + (size_t)(qrow0 + wave * 16 + fr) * D + h * 64 + fq * 4;
#pragma unroll
    for (int dt = 0; dt < 4; ++dt) { u32x2 w; w.x = cvt_pk_bf16(o[dt][0] * inv, o[dt][1] * inv); w.y = cvt_pk_bf16(o[dt][2] * inv, o[dt][3] * inv); *(u32x2*)(op + dt * 16) = w; }
}

#define GAS __attribute__((address_space(1)))
template <class P> __device__ __forceinline__ GAS P* uniform_ptr(P* p) {
    const unsigned long long v = (unsigned long long)p; const unsigned lo = __builtin_amdgcn_readfirstlane((unsigned)v), hi = __builtin_amdgcn_readfirstlane((unsigned)(v >> 32));
    return (GAS P*)(((unsigned long long)hi << 32) | lo);
}
__device__ __forceinline__ void conv_rows(GAS const float* glu, int u, int ch, float (&gv)[46]) {
    const int t0 = u * 16; int bs, be;
    if (t0 < TP) { bs = t0 & ~255; be = bs + 256; } else { bs = TP + ((t0 - TP) & ~1023); be = bs + 1024; }
#pragma unroll
    for (int r = 0; r < 46; ++r) {
        const int tr = t0 - 15 + r; const int trc = __builtin_amdgcn_readfirstlane(tr < bs ? bs : (tr >= be ? be - 1 : tr));
        GAS const float* rowp = glu + (size_t)trc * 512;
        gv[r] = rowp[(unsigned)ch];
    }
}
__device__ __forceinline__ void conv_phase(const float* glu_, const float* cw_, const float* cb, const float* cng, const float* cnb, bf16_t* MIX_, unsigned char* lds, int G_) {
    const int ch = threadIdx.x, lane = ch & 63, wave = ch >> 6;
    GAS const float* glu = uniform_ptr(glu_); GAS const float* cw = uniform_ptr(cw_); GAS bf16_t* MIX = uniform_ptr(MIX_); const int G = __builtin_amdgcn_readfirstlane(G_);
    float* tile = (float*)lds;
    float* stat = tile + 16 * 512;
    const float bias = cb[ch], g = cng[ch], b = cnb[ch];
    int u = blockIdx.x;
    if (u >= 768) return;
    for (; u < 768; u += G) {
        float gv[46];
        conv_rows(glu, u, ch, gv);
        const int t0 = u * 16; int bs, be;
        if (t0 < TP) { bs = t0 & ~255; be = bs + 256; } else { bs = TP + ((t0 - TP) & ~1023); be = bs + 1024; }
#pragma unroll
        for (int r = 0; r < 46; ++r) { const int tr = t0 - 15 + r; gv[r] = (tr >= bs && tr < be) ? gv[r] : 0.f; }
        float out[16];
#pragma unroll
        for (int i = 0; i < 16; ++i) out[i] = bias;
#pragma unroll
        for (int tap = 0; tap < 31; ++tap) {
            const float w = (cw + tap * 512)[(unsigned)ch];
#pragma unroll
            for (int i = 0; i < 16; ++i) out[i] += w * gv[i + tap];
        }
#pragma unroll
        for (int i = 0; i < 16; ++i) tile[i * 512 + ch] = out[i];
        __syncthreads();
#pragma unroll
        for (int tk = 0; tk < 2; ++tk) {
            const int tok = wave * 2 + tk;
            const f32x4 a = *(const f32x4*)(tile + tok * 512 + lane * 8), c = *(const f32x4*)(tile + tok * 512 + lane * 8 + 4);
            float s1 = a[0] + a[1] + a[2] + a[3] + c[0] + c[1] + c[2] + c[3];
            float s2 = a[0] * a[0] + a[1] * a[1] + a[2] * a[2] + a[3] * a[3] + c[0] * c[0] + c[1] * c[1] + c[2] * c[2] + c[3] * c[3];
#pragma unroll
            for (int o = 1; o < 64; o <<= 1) { s1 += __shfl_xor(s1, o); s2 += __shfl_xor(s2, o); }
            if (lane == 0) { const float mu = s1 * (1.f / 512.f), var = fmaxf(s2 * (1.f / 512.f) - mu * mu, 0.f); stat[tok * 2] = mu; stat[tok * 2 + 1] = rsqrtf(var + 1e-5f); }
        }
        __syncthreads();
#pragma unroll
        for (int i = 0; i < 16; ++i) {
            const float y = (out[i] - stat[2 * i]) * stat[2 * i + 1] * g + b;
            MIX[(size_t)(t0 + i) * D + 512 + ch] = f2bf(siluf_(y));
        }
        __syncthreads();
    }
}

__device__ __noinline__ void sgu_unit(const float* V, const bf16_t* U, int t0, int g, const float* sw  , const float* sb  ,
                                          const float* sng, const float* snb, bf16_t* MIX, unsigned char* lds) {
    const int tid = threadIdx.x, wave = tid >> 6, lane = tid & 63, fr = lane & 15, fq = lane >> 4;
    bf16_t* vT = (bf16_t*)lds;
    bf16_t* wS = vT + 128 * 136;
    float* st = (float*)(wS + 128 * 136);
#pragma unroll 1
    for (int hb = 0; hb < 2; ++hb) {
        f32x4 a[8], b[8];
#pragma unroll
        for (int i = 0; i < 8; ++i) { const float* vr = V + (size_t)(t0 + wave * 16 + hb * 8 + i) * 512 + lane * 8; a[i] = *(const f32x4*)vr; b[i] = *(const f32x4*)(vr + 4); }
        float s1[8], s2[8];
#pragma unroll
        for (int i = 0; i < 8; ++i) { s1[i] = a[i][0] + a[i][1] + a[i][2] + a[i][3] + b[i][0] + b[i][1] + b[i][2] + b[i][3];
            s2[i] = a[i][0] * a[i][0] + a[i][1] * a[i][1] + a[i][2] * a[i][2] + a[i][3] * a[i][3] + b[i][0] * b[i][0] + b[i][1] * b[i][1] + b[i][2] * b[i][2] + b[i][3] * b[i][3]; }
#pragma unroll
        for (int o = 1; o < 64; o <<= 1) {
#pragma unroll
            for (int i = 0; i < 8; ++i) { s1[i] += __shfl_xor(s1[i], o); s2[i] += __shfl_xor(s2[i], o); }
        }
#pragma unroll
        for (int i = 0; i < 8; ++i) if (lane == i) { const float mu = s1[i] * (1.f / 512.f), var = fmaxf(s2[i] * (1.f / 512.f) - mu * mu, 0.f); const int q = wave * 16 + hb * 8 + i; st[q * 2] = mu; st[q * 2 + 1] = rsqrtf(var + 1e-5f); }
    }
    for (int e = tid; e < 128 * 16; e += 512) { const int pp = e >> 4, q8 = (e & 15) * 8;
        const f32x4 a = *(const f32x4*)(sw + pp * 128 + q8), b = *(const f32x4*)(sw + pp * 128 + q8 + 4);
        u32x4 w; w.x = cvt_pk_bf16(a[0], a[1]); w.y = cvt_pk_bf16(a[2], a[3]); w.z = cvt_pk_bf16(b[0], b[1]); w.w = cvt_pk_bf16(b[2], b[3]);
        *(u32x4*)(wS + pp * 136 + q8) = w; }
    __syncthreads();
    for (int e = tid; e < 128 * 16; e += 512) { const int q = e & 127, c8 = (e >> 7) * 8;
        const float* vr = V + (size_t)(t0 + q) * 512 + g * 128 + c8;
        const f32x4 a = *(const f32x4*)vr, b = *(const f32x4*)(vr + 4);
        const float mu = st[q * 2], rs = st[q * 2 + 1];
        const f32x4 ga = *(const f32x4*)(sng + g * 128 + c8), gb = *(const f32x4*)(sng + g * 128 + c8 + 4), ba = *(const f32x4*)(snb + g * 128 + c8), bb = *(const f32x4*)(snb + g * 128 + c8 + 4);
        const f32x4 ya = (a - mu) * rs * ga + ba, yb = (b - mu) * rs * gb + bb;
#pragma unroll
        for (int i = 0; i < 4; ++i) { vT[(c8 + i) * 136 + q] = f2bf(ya[i]); vT[(c8 + 4 + i) * 136 + q] = f2bf(yb[i]); }
    }
    __syncthreads();
    f32x4 acc[8];
#pragma unroll
    for (int i = 0; i < 8; ++i) acc[i] = (f32x4){0.f, 0.f, 0.f, 0.f};
#pragma unroll
    for (int kk = 0; kk < 4; ++kk) {
        const bf16x8 bfr = *(const bf16x8*)(wS + (wave * 16 + fr) * 136 + kk * 32 + fq * 8);
#pragma unroll
        for (int ct = 0; ct < 8; ++ct) {
            const bf16x8 afr = *(const bf16x8*)(vT + (ct * 16 + fr) * 136 + kk * 32 + fq * 8);
            acc[ct] = __builtin_amdgcn_mfma_f32_16x16x32_bf16(afr, bfr, acc[ct], 0, 0, 0);
        }
    }
    const int pp = wave * 16 + fr; const float bias = sb[pp];
#pragma unroll
    for (int ct = 0; ct < 8; ++ct) {
        const int c = g * 128 + ct * 16 + fq * 4;
        const u32x2 uu = *(const u32x2*)(U + (size_t)(t0 + pp) * 512 + c);
        const float u0 = bf2f(uu.x & 0xffffu), u1 = bf2f(uu.x >> 16), u2 = bf2f(uu.y & 0xffffu), u3 = bf2f(uu.y >> 16);
        u32x2 w; w.x = cvt_pk_bf16(u0 * (acc[ct][0] + bias), u1 * (acc[ct][1] + bias)); w.y = cvt_pk_bf16(u2 * (acc[ct][2] + bias), u3 * (acc[ct][3] + bias));
        *(u32x2*)(MIX + (size_t)(t0 + pp) * D + 512 + c) = w;
    }
    __syncthreads();
}


__global__ void __launch_bounds__(512, 2) mega(Params p_unused) {
    extern __shared__ __attribute__((aligned(16))) unsigned char lds[];
    cg::grid_group grid = cg::this_grid();
    const int hi = kparams()->ph_hi;
    volatile LAS unsigned* bst = (volatile LAS unsigned*)((LAS unsigned char*)lds + 131072 + 64);
    if (threadIdx.x == 0) { bst[0] = 0u; bst[1] = 0u;
        if (hi - kparams()->ph_lo > 1) (void)xb_add(&((unsigned*)(KWS() + WS_BAR))[XB_XCNT(xb_xcc_id())], 1u); }
    __syncthreads();
    for (int ph = kparams()->ph_lo; ph < hi; ++ph) {
        const int G = gridDim.x;
        LAS unsigned char* ldsl = (LAS unsigned char*)lds;
        if (ph == 0) {
#ifndef NO_PRO
            for (int rp = 0; rp < DUPN(1); ++rp) { prologue((const Params*)kparams(), lds, G); __syncthreads(); }
#endif
        } else if (ph == 1) {
            if (blockIdx.x & 1) { shiftw_phase((const Params*)kparams(), G); pre_phase((const Params*)kparams(), G); }
            else { pre_phase((const Params*)kparams(), G); shiftw_phase((const Params*)kparams(), G); }
        } else {
            const int q = ph - 2, layer = q / 7, r = q % 7, j = layer >> 1;
            const int sub = (r < 2) ? 0 : (r < 5 ? 1 : 2), sidx = layer * 3 + sub;
            const bool first = (layer == 0 && sub == 0), lastsub = (layer == 3 && sub == 2);
            if (r == 0 || r == 5) {
#ifndef NO_F1
                unsigned char* ws = KWS();
                const int mat = layer * 2 + (sub >> 1);
                constexpr int M1 = 46 * 256;
                for (int rp = 0; rp < DUPN(4); ++rp) {
                    { pg8::Gemm g{(const bf16_t*)(ws + WS_H), (const bf16_t*)(ws + WS_WF1) + (size_t)mat * 5632 * D, M1, 5632, D}; pg8::StaticOrder S; S.init(M1, 5632, G, blockIdx.x, 256);
                      const EpiSwiglu<256> E{(bf16_t*)(ws + WS_HID), (const float*)(ws + WS_RSS) + (size_t)sidx * T, (const float*)(ws + WS_SW) + (size_t)mat * 5 * 5632, 0};
                      pg8::gemm_phase<256>(ldsl, g, S, E); }
                    { pg8::Gemm g{(const bf16_t*)(ws + WS_H) + (size_t)M1 * D, (const bf16_t*)(ws + WS_WF1) + (size_t)mat * 5632 * D, T - M1, 5632, D}; pg8::StaticOrder S; S.init(T - M1, 5632, G, G - 1 - (int)blockIdx.x, 128);
                      const EpiSwiglu<128> E{(bf16_t*)(ws + WS_HID), (const float*)(ws + WS_RSS) + (size_t)sidx * T, (const float*)(ws + WS_SW) + (size_t)mat * 5 * 5632, M1};
                      pg8::gemm_phase<128>(ldsl, g, S, E); }
                }
#endif
            } else if (r == 1 || r == 6 || r == 4) {
#ifndef NO_F2
                unsigned char* ws = KWS();
                const int mat = layer * 2 + (sub >> 1);
                pg8::Gemm g;
                if (r == 4) g = pg8::Gemm{(const bf16_t*)(ws + WS_MIX), (const bf16_t*)(ws + ((layer & 1) ? WS_WOO : WS_WEO)) + (size_t)j * D * D, T, D, D};
                else g = pg8::Gemm{(const bf16_t*)(ws + WS_HID), (const bf16_t*)(ws + WS_WF2) + (size_t)mat * D * FFN, T, D, FFN};
                pg8::StaticOrder S; S.init(T, D, G, blockIdx.x, GT);
                const EpiResid<GT> ER{layer, sub};
                pg8::gemm_phase<GT>(ldsl, g, S, ER);
#endif
            } else if ((layer & 1) == 0) {
                if (r == 2) {
#ifndef NO_EI
                    unsigned char* ws = KWS();
                    pg8::Gemm g{(const bf16_t*)(ws + WS_H), (const bf16_t*)(ws + WS_WEI) + (size_t)j * 1792 * D, T, 1792, D}; pg8::StaticOrder S; S.init(T, 1792, G, blockIdx.x, GT);
                    const EpiEvenIn<GT> E{j, sidx};
                    for (int rp = 0; rp < DUPN(8); ++rp) pg8::gemm_phase<GT>(ldsl, g, S, E);
#endif
                } else {
                    for (int pass = 0; pass < 2; ++pass) {
                    const bool conv_pass = ((pass == 0) == ((blockIdx.x & 1) != 0));
#ifndef NO_ATT
                    for (int rp = 0; rp < (conv_pass ? 0 : DUPN(16)); ++rp) {
                    unsigned char* ws = KWS();
                    const bf16_t* Ks = (const bf16_t*)(ws + WS_KS) + (size_t)j * 4 * 2 * 1536 * 64; const bf16_t* VsT = (const bf16_t*)(ws + WS_VST) + (size_t)j * 4 * 2 * 64 * 1536;
                    bf16_t* MIX = (bf16_t*)(ws + WS_MIX);
                    for (int u = blockIdx.x; u < 768; u += G) {
                        if (u < 256) { const int b = u >> 6, h = (u >> 3) & 7, qt = u & 7, kvh = h >> 2;
                            attn_unit((const bf16_t*)(ws + WS_Q), TP + b * 1024 + qt * 128, h, Ks + (size_t)(b * 2 + kvh) * 1536 * 64, VsT + (size_t)(b * 2 + kvh) * 64 * 1536, 1536, MIX, lds);
                        } else { const int v = u - 256, b = v >> 4, h = (v >> 1) & 7, qt = v & 1, kvh = h >> 2;
                            attn_unit((const bf16_t*)(ws + WS_Q), b * 256 + qt * 128, h, (const bf16_t*)(ws + WS_KP) + (size_t)(b * 2 + kvh) * 256 * 64, (const bf16_t*)(ws + WS_VPT) + (size_t)(b * 2 + kvh) * 64 * 256, 256, MIX, lds); }
                    }
                    }
#endif
#ifndef NO_CONV
                    for (int rp = 0; rp < (conv_pass ? DUPN(32) : 0); ++rp) {
                    unsigned char* ws = KWS();
                    conv_phase((const float*)(ws + WS_GLU), KIN(15) + (size_t)j * 31 * 512, KIN(16) + j * 512, KIN(17) + j * 512, KIN(18) + j * 512, (bf16_t*)(ws + WS_MIX), lds, G);
                    }
#endif
                    __syncthreads();
                    }
                }
            } else {
                if (r == 2) {
#ifndef NO_OI
                    unsigned char* ws = KWS();
                    pg8::Gemm g{(const bf16_t*)(ws + WS_H), (const bf16_t*)(ws + WS_WOI) + (size_t)j * 2048 * D, T, 2048, D}; pg8::StaticOrder S; S.init(T, 2048, G, blockIdx.x, GT);
                    const EpiOddIn<GT> E{(bf16_t*)(ws + WS_FTP), (bf16_t*)(ws + WS_FTS), (bf16_t*)(ws + WS_U), (float*)(ws + WS_V), (const float*)(ws + WS_RSS) + (size_t)sidx * T, (const float*)(ws + WS_SW) + SW_OI + (size_t)j * 5 * 2048};
                    for (int rp = 0; rp < DUPN(8); ++rp) pg8::gemm_phase<GT>(ldsl, g, S, E);
#endif
                } else {
#ifndef NO_FOUR
                    for (int which = 0; which < 2 * DUPN(64); ++which) {
                        unsigned char* ws = KWS();
                        pg8::Gemm g; pg8::StaticOrder S; EpiFourier E;
                        if ((which & 1) == 0) { g = pg8::Gemm{(const bf16_t*)(ws + WS_D1024), (const bf16_t*)(ws + WS_FTS), 1024, 2048, 2048}; S.init(1024, 2048, G, blockIdx.x); E = EpiFourier{(bf16_t*)(ws + WS_MIX), TP, 1024}; }
                        else { g = pg8::Gemm{(const bf16_t*)(ws + WS_D256), (const bf16_t*)(ws + WS_FTP), 256, 16384, 512}; S.init(256, 16384, G, (blockIdx.x + G - (32 % G)) % G); E = EpiFourier{(bf16_t*)(ws + WS_MIX), 0, 256}; }
                        pg8::gemm_phase<256>(ldsl, g, S, E);
                    }
#endif
#ifndef NO_SGU
                    for (int rp = 0; rp < DUPN(128); ++rp) {
                    unsigned char* ws = KWS();
                    const bool g256 = (G == 256);
                    for (int u = g256 ? (blockIdx.x >= 32 ? 255 - (int)blockIdx.x : 384) : (int)blockIdx.x; u < 384; u += (g256 ? 224 : G)) {
                        const int ch = u >> 2, g = u & 3;
                        sgu_unit((const float*)(ws + WS_V), (const bf16_t*)(ws + WS_U), ch * 128, g, KIN(23) + ((size_t)j * 4 + g) * 128 * 128, KIN(24) + (j * 4 + g) * 128,
                                 KIN(21) + j * 512, KIN(22) + j * 512, (bf16_t*)(ws + WS_MIX), lds);
                    }
                    }
#endif
                }
            }
        }
        if (ph + 1 < hi) {
            unsigned* bar = (unsigned*)(KWS() + WS_BAR);
            if (hi > (1 << 20)) grid.sync();
            xcd_barrier(bar, bst); if (DUP_MASK & 256) xcd_barrier(bar, bst);
        }
    }
}

extern "C" void kernel_launch(void* const* d_in, const int* in_sizes, int n_in, void* d_out, int out_size, void* d_ws, size_t ws_size, hipStream_t stream) {
    static int grid = 0;
    if (grid == 0) {
        if (n_in != 25 || ws_size < WS_END) { fprintf(stderr, "kernel_launch: unexpected n_in %d / ws_size %zu\n", n_in, ws_size); grid = -1; return; }
        int dev = 0, cus = 0, per_cu = 0;
        hipGetDevice(&dev);
        hipDeviceGetAttribute(&cus, hipDeviceAttributeMultiprocessorCount, dev);
        if (hipFuncSetAttribute((const void*)mega, hipFuncAttributeMaxDynamicSharedMemorySize, LDS_BYTES) != hipSuccess) { fprintf(stderr, "kernel_launch: hipFuncSetAttribute failed\n"); grid = -1; return; }
        if (hipOccupancyMaxActiveBlocksPerMultiprocessor(&per_cu, (const void*)mega, 512, LDS_BYTES) != hipSuccess || per_cu < 1) { fprintf(stderr, "kernel_launch: occupancy query failed (%d)\n", per_cu); grid = -1; return; }
        grid = cus;
    }
    if (grid < 0) return;
    if (hipMemsetAsync((char*)d_ws + WS_BAR, 0, XCD_BAR_WORDS * 4, stream) != hipSuccess) { fprintf(stderr, "kernel_launch: hipMemsetAsync failed\n"); return; }
    Params p{};
    for (int i = 0; i < 25; ++i) p.in[i] = (const float*)d_in[i];
    p.out = (float*)d_out; p.ws = (unsigned char*)d_ws;
#if ONE_LAUNCH
    p.ph_lo = 0; p.ph_hi = NPH;
    void* args[] = {&p};
    hipError_t e = hipLaunchCooperativeKernel((const void*)mega, dim3(grid), dim3(512), args, LDS_BYTES, stream);
    if (e != hipSuccess) fprintf(stderr, "cooperative launch failed: %s (grid %d)\n", hipGetErrorString(e), grid);
#else
    for (int ph = 0; ph < NPH; ++ph) { p.ph_lo = ph; p.ph_hi = ph + 1; hipLaunchKernelGGL(mega, dim3(grid), dim3(512), LDS_BYTES, stream, p); }
#endif
}
```

```cpp
#include <hip/hip_runtime.h>
#include <hip/hip_cooperative_groups.h>
#include <cstdio>
#include <cstdint>
namespace cg = cooperative_groups;

#ifndef DUP_MASK
#define DUP_MASK 0
#endif
#define DUPN(bit) ((DUP_MASK & (bit)) ? 2 : 1)
#ifndef ONE_LAUNCH
#define ONE_LAUNCH 1
#endif

#define LAS __attribute__((address_space(3)))
typedef unsigned short bf16_t;
typedef short bf16x8 __attribute__((ext_vector_type(8)));
typedef float f32x4 __attribute__((ext_vector_type(4)));
typedef unsigned u32x4 __attribute__((ext_vector_type(4)));
typedef unsigned u32x2 __attribute__((ext_vector_type(2)));

constexpr int D = 1024, TP = 8192, TS = 4096, T = TP + TS, FFN = 2816;
constexpr int NPH = 30;
#ifndef GT_ROWS
#define GT_ROWS 192
#endif
constexpr int GT = GT_ROWS;
constexpr float C2 = 0.125f * 1.4426950408889634f;

constexpr size_t MiB = 1u << 20;
constexpr size_t WS_WF1 = 0, WS_WF2 = 88 * MiB, WS_WEI = 132 * MiB, WS_WEO = 139 * MiB, WS_WOI = 143 * MiB, WS_WOO = 151 * MiB;
constexpr size_t WS_D256 = 155 * MiB, WS_D1024 = 156 * MiB, WS_MOD = 160 * MiB, WS_ROPE = 161 * MiB, WS_X = 162 * MiB, WS_H = 210 * MiB;
constexpr size_t WS_HID = 234 * MiB, WS_Q = 300 * MiB, WS_KP = 312 * MiB, WS_VPT = 314 * MiB, WS_KS = 316 * MiB, WS_VST = 319 * MiB;
constexpr size_t WS_GLU = 322 * MiB, WS_MIX = 346 * MiB, WS_U = 370 * MiB, WS_V = 382 * MiB, WS_FTP = 406 * MiB, WS_FTS = 422 * MiB, WS_BAR = 430 * MiB, WS_RSS = 431 * MiB, WS_GS = 432 * MiB, WS_SW = 433 * MiB, WS_END = 435 * MiB;
constexpr int SW_EI = 8 * 5 * 5632, SW_OI = SW_EI + 2 * 5 * 1792;

constexpr int LDS_BYTES = 131072 + 2048;

struct Params { const float* in[25]; float* out; unsigned char* ws; int ph_lo, ph_hi; };

__device__ __forceinline__ unsigned cvt_pk_bf16(float lo, float hi) { unsigned r; asm volatile("v_cvt_pk_bf16_f32 %0, %1, %2" : "=v"(r) : "v"(lo), "v"(hi)); return r; }
__device__ __forceinline__ bf16_t f2bf(float f) { return (bf16_t)(cvt_pk_bf16(f, 0.f) & 0xffffu); }
__device__ __forceinline__ float bf2f(unsigned h) { return __builtin_bit_cast(float, h << 16); }
typedef _Float16 f16x2 __attribute__((ext_vector_type(2)));
__device__ __forceinline__ unsigned pk_f16(float lo, float hi) { const f16x2 v = {(_Float16)lo, (_Float16)hi}; return __builtin_bit_cast(unsigned, v); }
__device__ __forceinline__ float f16lo(unsigned w) { return (float)__builtin_bit_cast(f16x2, w)[0]; }
__device__ __forceinline__ float f16hi(unsigned w) { return (float)__builtin_bit_cast(f16x2, w)[1]; }
__device__ __forceinline__ float wave_sum(float v) {
#pragma unroll
    for (int o = 1; o < 64; o <<= 1) v += __shfl_xor(v, o);
    return v;
}
__device__ __forceinline__ float sigmoidf_(float x) { return __builtin_amdgcn_rcpf(1.f + __expf(-x)); }
__device__ __forceinline__ float siluf_(float x) { return x * sigmoidf_(x); }

namespace pg8 {
constexpr int BM = 256, BK = 64, HALF = 128, HTB = HALF * BK * 2, NXCD = 8, WGM = 8;
__device__ __forceinline__ int lds_byte(int r, int c) { const int st = (r >> 4) * 2 + (c >> 5), rr = r & 15, cc = c & 31, ob = rr * 64 + cc * 2; return st * 1024 + (ob ^ (((ob >> 9) & 1) << 5)); }
__device__ __forceinline__ void stage_rc(int b, int& R, int& C) { const int st = b / 1024, sb = b % 1024, swz = sb ^ (((sb >> 9) & 1) << 5); R = (st >> 1) * 16 + swz / 64; C = (st & 1) * 32 + (swz % 64) / 2; }
__device__ __forceinline__ int perm32(int rho) { const int n = rho >> 4, i = rho & 15; return 8 * (i >> 2) + 4 * n + (i & 3); }

struct Unit { int pm, pn; };
struct Gemm { const bf16_t* A; const bf16_t* Bt; int M, N, K; };

struct StaticOrder {
    int nM, nN, nwg, G, c;
    __device__ void init(int M, int N, int G_, int c_, int TM = 256) { nM = M / TM; nN = N / BM; nwg = nM * nN; G = G_; c = c_; }
    __device__ bool next(int i, Unit& u) const {
        const long L = (long)i * G + c; if (L >= nwg) return false;
        int wgid = (int)L; { const int q = nwg / NXCD, r = nwg % NXCD, xcd = wgid % NXCD, off = wgid / NXCD; wgid = (xcd < r ? xcd * (q + 1) : r * (q + 1) + (xcd - r) * q) + off; }
        const int nig = WGM * nN, gid = wgid / nig, fm = gid * WGM, gsz = (nM - fm) < WGM ? (nM - fm) : WGM;
        u.pm = fm + ((wgid % nig) % gsz); u.pn = (wgid % nig) / gsz; return true;
    }
};

template <int TM, class Epi>
__device__ __forceinline__ void gemm_phase(LAS unsigned char* lds, const Gemm g, const StaticOrder& S, const Epi& E) {
    int tid_ = threadIdx.x; asm volatile("" : "+v"(tid_));
    const int tid = tid_, wid = __builtin_amdgcn_readfirstlane(tid >> 6), lane = tid & 63, wr = wid >> 2, wc = wid & 3, fr = lane & 15, fq = lane >> 4;
    const int K = g.K, nt = K / BK;
    constexpr int HA = TM / 2, HTA = HA * BK * 2, MT = TM / 64;
    constexpr int NA = (TM == 128) ? 1 : 2;
    unsigned voffA[2], voffB[2], ldsA[2];
#pragma unroll
    for (int i = 0; i < 2; ++i) { int R, C; stage_rc(tid * 16 + i * 8192, R, C); const int Rb = (R & ~31) + perm32(R & 31);
        voffB[i] = (unsigned)(Rb * K + C) * 2u;
        const bool okA = (tid * 16 + i * 8192) < HTA;
        int Ra, Ca; stage_rc(tid * 16 + (okA ? i * 8192 : 0), Ra, Ca);
        voffA[i] = (unsigned)(Ra * K + Ca) * 2u; ldsA[i] = okA ? (unsigned)i * 8192u : 0u; }
    const size_t kstep = (size_t)(BK * 2);
    const size_t hstep = (size_t)HALF * K * 2;
    const size_t tstep = 2 * hstep;
    const size_t hstepA = (size_t)HA * K * 2, tstepA = 2 * hstepA;
    const unsigned ldsw = (unsigned)wid * 1024u;
    const int aoff = lds_byte(wr * (HA / 2) + fr, fq * 8), boff = lds_byte(wc * 32 + fr, fq * 8);
#define PG8_SA(b, h) (((b) * 2 + (h)) * HTA)
#define PG8_SB(b, h) (4 * HTA + ((b) * 2 + (h)) * HTB)
#define PG8_STAGE(bufoff, gbase, voff) do { _Pragma("unroll") for (int _i = 0; _i < 2; ++_i) \
        __builtin_amdgcn_global_load_lds((const unsigned*)((const char*)(gbase) + (voff)[_i]), (LAS unsigned*)(lds + (bufoff) + ldsw + _i * 8192), 16, 0, 0); } while (0)
#define PG8_STAGEA(bufoff, gbase) do { _Pragma("unroll") for (int _i = 0; _i < NA; ++_i) \
        __builtin_amdgcn_global_load_lds((const unsigned*)((const char*)(gbase) + voffA[_i]), (LAS unsigned*)(lds + (bufoff) + ldsw + ldsA[_i]), 16, 0, 0); } while (0)
#define PG8_LDA(dst, b, h) do { _Pragma("unroll") for (int m = 0; m < MT; ++m) _Pragma("unroll") for (int k = 0; k < 2; ++k) dst[m][k] = *(const LAS bf16x8*)(lds + PG8_SA(b, h) + aoff + m * 2048 + k * 1024); } while (0)
#define PG8_LDB(dst, b, h) do { _Pragma("unroll") for (int n = 0; n < 2; ++n) _Pragma("unroll") for (int k = 0; k < 2; ++k) dst[n][k] = *(const LAS bf16x8*)(lds + PG8_SB(b, h) + boff + n * 2048 + k * 1024); } while (0)
#define PG8_MMA(ai, bj, At, Bt) do { __builtin_amdgcn_s_setprio(1); _Pragma("unroll") for (int m = 0; m < MT; ++m) _Pragma("unroll") for (int n = 0; n < 2; ++n) _Pragma("unroll") for (int k = 0; k < 2; ++k) \
        acc[ai][bj][m][n] = __builtin_amdgcn_mfma_f32_16x16x32_bf16(Bt[n][k], At[m][k], acc[ai][bj][m][n], 0, 0, 0); __builtin_amdgcn_s_setprio(0); } while (0)
#define PG8_WAIT_V(n) asm volatile("s_waitcnt vmcnt(" #n ")" ::: "memory")
#define PG8_WAIT_LOOP do { if constexpr (NA == 2) PG8_WAIT_V(8); else PG8_WAIT_V(6); } while (0)
#define PG8_WAIT_L(n) asm volatile("s_waitcnt lgkmcnt(" #n ")" ::: "memory")
#define PG8_BAR __builtin_amdgcn_s_barrier()
#define PG8_SCHED __builtin_amdgcn_sched_barrier(0)
    Unit cur, nxt; int ui = 0;
    if (!S.next(0, cur)) return;
    f32x4 acc[2][2][MT][2];
#pragma unroll
    for (int a = 0; a < 2; ++a)
#pragma unroll
        for (int b = 0; b < 2; ++b)
#pragma unroll
            for (int m = 0; m < MT; ++m)
#pragma unroll
                for (int n = 0; n < 2; ++n) acc[a][b][m][n] = (f32x4){0.f, 0.f, 0.f, 0.f};
    bf16x8 At[MT][2], B0[2][2], B1[2][2];
    const char* cA = (const char*)g.A + (size_t)cur.pm * tstepA; const char* cB = (const char*)g.Bt + (size_t)cur.pn * tstep;
    PG8_STAGE(PG8_SB(0, 0), cB, voffB); PG8_STAGE(PG8_SB(0, 1), cB + hstep, voffB); PG8_STAGEA(PG8_SA(0, 0), cA); PG8_STAGEA(PG8_SA(0, 1), cA + hstepA);
    if (wr == 1) PG8_BAR;
    if constexpr (NA == 2) PG8_WAIT_V(2); else PG8_WAIT_V(1);
    PG8_BAR;
    PG8_STAGE(PG8_SB(1, 0), cB + kstep, voffB); PG8_STAGEA(PG8_SA(1, 0), cA + kstep); PG8_STAGE(PG8_SB(1, 1), cB + hstep + kstep, voffB);
    if constexpr (NA == 2) PG8_WAIT_V(6); else PG8_WAIT_V(5);
    PG8_BAR;
    for (;;) {
        const bool has_next = S.next(ui + 1, nxt);
        const char* nA = has_next ? (const char*)g.A + (size_t)nxt.pm * tstepA : cA; const char* nB = has_next ? (const char*)g.Bt + (size_t)nxt.pn * tstep : cB;
        for (int t = 0; t < nt; t += 2) {
            const bool last = (t == nt - 2);
            const char* a1 = cA + (size_t)(t + 1) * kstep;
            const char* a2 = last ? nA : cA + (size_t)(t + 2) * kstep; const char* b2 = last ? nB : cB + (size_t)(t + 2) * kstep;
            const char* a3 = a2 + kstep; const char* b3 = b2 + kstep;
            PG8_LDB(B0, 0, 0); PG8_LDB(B1, 0, 1); PG8_SCHED; PG8_LDA(At, 0, 0); PG8_STAGEA(PG8_SA(1, 1), a1 + hstepA);
            PG8_WAIT_LOOP; PG8_WAIT_L(0); PG8_BAR; PG8_MMA(0, 0, At, B0); PG8_MMA(0, 1, At, B1); PG8_BAR; PG8_SCHED;
            PG8_LDA(At, 0, 1); PG8_STAGE(PG8_SB(0, 0), b2, voffB); PG8_STAGE(PG8_SB(0, 1), b2 + hstep, voffB); PG8_STAGEA(PG8_SA(0, 0), a2);
            PG8_WAIT_LOOP; PG8_WAIT_L(0); PG8_BAR; PG8_MMA(1, 0, At, B0); PG8_MMA(1, 1, At, B1); PG8_BAR; PG8_SCHED;
            PG8_LDB(B0, 1, 0); PG8_LDB(B1, 1, 1); PG8_SCHED; PG8_LDA(At, 1, 0); PG8_STAGEA(PG8_SA(0, 1), a2 + hstepA);
            PG8_WAIT_LOOP; PG8_WAIT_L(0); PG8_BAR; PG8_MMA(0, 0, At, B0); PG8_MMA(0, 1, At, B1); PG8_BAR; PG8_SCHED;
            PG8_LDA(At, 1, 1); PG8_STAGE(PG8_SB(1, 0), b3, voffB); PG8_STAGE(PG8_SB(1, 1), b3 + hstep, voffB); PG8_STAGEA(PG8_SA(1, 0), a3);
            PG8_WAIT_LOOP; PG8_WAIT_L(0); PG8_BAR; PG8_MMA(1, 0, At, B0); PG8_MMA(1, 1, At, B1); PG8_BAR; PG8_SCHED;
        }
        if (wr == 0) PG8_BAR;
        E(acc, cur, wr, wc, fr, fq);
        if (!has_next) break;
#pragma unroll
        for (int a = 0; a < 2; ++a)
#pragma unroll
            for (int b = 0; b < 2; ++b)
#pragma unroll
                for (int m = 0; m < MT; ++m)
#pragma unroll
                    for (int n = 0; n < 2; ++n) acc[a][b][m][n] = (f32x4){0.f, 0.f, 0.f, 0.f};
        cur = nxt; cA = nA; cB = nB; ++ui;
        if (wr == 1) PG8_BAR;
    }
    PG8_WAIT_V(0);
    PG8_BAR;
#undef PG8_SA
#undef PG8_SB
#undef PG8_STAGE
#undef PG8_STAGEA
#undef PG8_LDA
#undef PG8_LDB
#undef PG8_MMA
#undef PG8_WAIT_V
#undef PG8_WAIT_L
#undef PG8_WAIT_LOOP
#undef PG8_BAR
#undef PG8_SCHED
}
}
using pg8::Unit;
#define ACCREF(TM) const f32x4 (&acc)[2][2][(TM) / 64][2]

typedef const Params __attribute__((address_space(4)))* KP;
__device__ __forceinline__ KP kparams() { KP kp = (KP)__builtin_amdgcn_kernarg_segment_ptr(); asm volatile("" : "+s"(kp)); return kp; }
#define KIN(i) ((const float*)kparams()->in[i])
#define KWS() ((unsigned char*)kparams()->ws)
#define KOUT() ((float*)kparams()->out)

template <int TM> struct EpiSwiglu {
    static_assert(TM == 256 || TM == 128, "128/256-row tiles never straddle a conditioning group");
    bf16_t* HID; const float* rss; const float* sW; int row_base;
    __device__ __forceinline__ void operator()(ACCREF(TM), const Unit& u, int wr, int wc, int fr, int fq) const {
        const int row0 = row_base + u.pm * TM + wr * (TM / 4) + fr, col0 = u.pn * 128 + wc * 32 + fq * 8;
        const int trow = row_base + u.pm * TM, cond = trow < TP ? 0 : 1 + ((trow - TP) >> 10);
        const float* sw = sW + (size_t)cond * 5632 + u.pn * 256 + wc * 32 + fq * 8;
        const f32x4 sg0 = *(const f32x4*)(sw), sg1 = *(const f32x4*)(sw + 4), su0 = *(const f32x4*)(sw + 128), su1 = *(const f32x4*)(sw + 132);
        float rs[2][TM / 64];
#pragma unroll
        for (int ai = 0; ai < 2; ++ai)
#pragma unroll
            for (int m = 0; m < TM / 64; ++m) rs[ai][m] = rss[row0 + ai * (TM / 2) + m * 16];
#pragma unroll
        for (int ai = 0; ai < 2; ++ai)
#pragma unroll
            for (int m = 0; m < TM / 64; ++m) {
                const float r = rsqrtf(rs[ai][m] * (1.f / 1024.f) + 1e-6f);
                const f32x4 g0 = acc[ai][0][m][0] * r + sg0, g1 = acc[ai][0][m][1] * r + sg1, u0 = acc[ai][1][m][0] * r + su0, u1 = acc[ai][1][m][1] * r + su1;
                u32x4 w;
                w.x = cvt_pk_bf16(siluf_(g0[0]) * u0[0], siluf_(g0[1]) * u0[1]); w.y = cvt_pk_bf16(siluf_(g0[2]) * u0[2], siluf_(g0[3]) * u0[3]);
                w.z = cvt_pk_bf16(siluf_(g1[0]) * u1[0], siluf_(g1[1]) * u1[1]); w.w = cvt_pk_bf16(siluf_(g1[2]) * u1[2], siluf_(g1[3]) * u1[3]);
                *(u32x4*)(HID + (size_t)(row0 + ai * (TM / 2) + m * 16) * FFN + col0) = w;
            }
    }
};

template <int TM> struct EpiResid {
    int layer, sub;
    __device__ __forceinline__ void operator()(ACCREF(TM), const Unit& u, int wr, int wc, int fr, int fq) const {
        constexpr int MT = TM / 64;
        unsigned char* ws = KWS();
        const int sidx = layer * 3 + sub;
        const bool first = (sidx == 0), lastsub = (sidx == 11);
        bf16_t* Xb = (bf16_t*)(ws + WS_X);
        const float* xin_p = KIN(0); const float* xin_s = KIN(1);
        float* xout = KOUT();
        const float* gate = (const float*)(ws + WS_MOD) + (size_t)layer * 5 * 9216 + (3 * sub + 2) * 1024;
        const float coef = (sub == 1) ? 1.f : 0.5f;
        const bool has_next = !lastsub;
        const float* gsn = (const float*)(ws + WS_GS) + (size_t)(sidx + 1) * 5 * 1024; float* rssn = (float*)(ws + WS_RSS) + (size_t)(sidx + 1) * T; bf16_t* XS = (bf16_t*)(ws + WS_H);
        const int row0 = u.pm * TM + wr * (TM / 4) + fr, col0 = u.pn * 256 + wc * 32 + fq * 8;
        const int tr0 = u.pm * TM, c_lo = tr0 < TP ? 0 : 1 + ((tr0 - TP) >> 10), c_hi = (tr0 + TM - 1) < TP ? 0 : 1 + ((tr0 + TM - 1 - TP) >> 10);
        const bool cuni = (c_lo == c_hi);
        f32x4 gvu[2][2], qu[2][2];
#pragma unroll
        for (int bj = 0; bj < 2; ++bj)
#pragma unroll
            for (int n = 0; n < 2; ++n) { gvu[bj][n] = *(const f32x4*)(gate + (size_t)c_lo * 9216 + col0 + bj * 128 + 4 * n); qu[bj][n] = *(const f32x4*)(gsn + (size_t)c_lo * 1024 + col0 + bj * 128 + 4 * n); }
#pragma unroll
        for (int ai = 0; ai < 2; ++ai) {
            f32x4 xv[MT][2][2];
#pragma unroll
            for (int m = 0; m < MT; ++m) {
                const int row = row0 + ai * (TM / 2) + m * 16;
                const int cond = row < TP ? 0 : 1 + ((row - TP) >> 10);
                if (first) {
                    const float* xi = ((row < TP) ? xin_p : (xin_s - (size_t)TP * D)) + (size_t)row * D + col0;
#pragma unroll
                    for (int bj = 0; bj < 2; ++bj)
#pragma unroll
                        for (int n = 0; n < 2; ++n) xv[m][bj][n] = *(const f32x4*)(xi + bj * 128 + 4 * n);
                } else {
#pragma unroll
                    for (int bj = 0; bj < 2; ++bj) {
                        const u32x4 w = *(const u32x4*)(Xb + (size_t)row * D + col0 + bj * 128);
                        xv[m][bj][0] = (f32x4){f16lo(w.x), f16hi(w.x), f16lo(w.y), f16hi(w.y)};
                        xv[m][bj][1] = (f32x4){f16lo(w.z), f16hi(w.z), f16lo(w.w), f16hi(w.w)};
                    }
                }
            }
#pragma unroll
            for (int m = 0; m < MT; ++m) {
                const int row = row0 + ai * (TM / 2) + m * 16;
                const int cond = row < TP ? 0 : 1 + ((row - TP) >> 10);
                const size_t ro = (size_t)row * D + col0;
                f32x4 xn[2][2];
#pragma unroll
                for (int bj = 0; bj < 2; ++bj)
#pragma unroll
                    for (int n = 0; n < 2; ++n) xn[bj][n] = xv[m][bj][n] + (cuni ? gvu[bj][n] : *(const f32x4*)(gate + (size_t)cond * 9216 + col0 + bj * 128 + 4 * n)) * coef * acc[ai][bj][m][n];
                if (has_next) {
                    const float* gq = gsn + (size_t)cond * 1024 + col0;
                    const f32x4 q00 = cuni ? qu[0][0] : *(const f32x4*)(gq), q01 = cuni ? qu[0][1] : *(const f32x4*)(gq + 4), q10 = cuni ? qu[1][0] : *(const f32x4*)(gq + 128), q11 = cuni ? qu[1][1] : *(const f32x4*)(gq + 132);
                    float ss = 0.f;
#pragma unroll
                    for (int bj = 0; bj < 2; ++bj) {
                        const f32x4 a = xn[bj][0], c = xn[bj][1];
                        ss += a[0] * a[0] + a[1] * a[1] + a[2] * a[2] + a[3] * a[3] + c[0] * c[0] + c[1] * c[1] + c[2] * c[2] + c[3] * c[3];
                        const f32x4 sa = a * (bj ? q10 : q00), sc = c * (bj ? q11 : q01);
                        u32x4 w; w.x = cvt_pk_bf16(sa[0], sa[1]); w.y = cvt_pk_bf16(sa[2], sa[3]); w.z = cvt_pk_bf16(sc[0], sc[1]); w.w = cvt_pk_bf16(sc[2], sc[3]);
                        *(u32x4*)(XS + ro + bj * 128) = w;
                    }
                    ss += __shfl_xor(ss, 16); ss += __shfl_xor(ss, 32);
                    if (fq == 0) (void)__hip_atomic_fetch_add(rssn + row, ss, __ATOMIC_RELAXED, __HIP_MEMORY_SCOPE_AGENT);
                }
                if (lastsub) {
#pragma unroll
                    for (int bj = 0; bj < 2; ++bj)
#pragma unroll
                        for (int n = 0; n < 2; ++n) *(f32x4*)(xout + ro + bj * 128 + 4 * n) = xn[bj][n];
                } else {
#pragma unroll
                    for (int bj = 0; bj < 2; ++bj) { const f32x4 a = xn[bj][0], c = xn[bj][1]; u32x4 w; w.x = pk_f16(a[0], a[1]); w.y = pk_f16(a[2], a[3]); w.z = pk_f16(c[0], c[1]); w.w = pk_f16(c[2], c[3]);
                        *(u32x4*)(Xb + ro + bj * 128) = w; }
                }
            }
        }
    }
};

template <int TM> struct EpiEvenIn {
    int j, s;
    __device__ __forceinline__ void operator()(ACCREF(TM), const Unit& u, int wr, int wc, int fr, int fq) const {
        constexpr int MT = TM / 64;
        const int pn = u.pn, rowb = u.pm * TM + wr * (TM / 4) + fr;
        unsigned char* ws = KWS();
        const float* rss = (const float*)(ws + WS_RSS) + (size_t)s * T;
        const float* sWb = (const float*)(ws + WS_SW) + SW_EI + (size_t)j * 5 * 1792 + pn * 256 + wc * 32 + fq * 8;
        const int tr0 = u.pm * TM, c_lo = tr0 < TP ? 0 : 1 + ((tr0 - TP) >> 10), c_hi = (tr0 + TM - 1) < TP ? 0 : 1 + ((tr0 + TM - 1 - TP) >> 10);
        const bool cuni = (c_lo == c_hi);
        f32x4 su[2][2];
#pragma unroll
        for (int bj = 0; bj < 2; ++bj)
#pragma unroll
            for (int n = 0; n < 2; ++n) su[bj][n] = *(const f32x4*)(sWb + (size_t)c_lo * 1792 + 128 * bj + 4 * n);
        float rsv[2][MT];
#pragma unroll
        for (int ai = 0; ai < 2; ++ai)
#pragma unroll
            for (int m = 0; m < MT; ++m) rsv[ai][m] = rsqrtf(rss[rowb + ai * (TM / 2) + m * 16] * (1.f / 1024.f) + 1e-6f);
        if (pn >= 3) {
            float* glu = (float*)(ws + WS_GLU);
#pragma unroll
            for (int ai = 0; ai < 2; ++ai)
#pragma unroll
                for (int m = 0; m < MT; ++m) {
                    const int row = rowb + ai * (TM / 2) + m * 16;
                    const float rs = rsv[ai][m];
                    const float* sw = sWb + (size_t)(row < TP ? 0 : 1 + ((row - TP) >> 10)) * 1792;
                    float* o = glu + (size_t)row * 512 + (pn - 3) * 128 + wc * 32 + fq * 8;
#pragma unroll
                    for (int n = 0; n < 2; ++n) {
                        const f32x4 a = acc[ai][0][m][n] * rs + (cuni ? su[0][n] : *(const f32x4*)(sw + 4 * n)), b = acc[ai][1][m][n] * rs + (cuni ? su[1][n] : *(const f32x4*)(sw + 128 + 4 * n));
                        f32x4 r; r[0] = a[0] * sigmoidf_(b[0]); r[1] = a[1] * sigmoidf_(b[1]); r[2] = a[2] * sigmoidf_(b[2]); r[3] = a[3] * sigmoidf_(b[3]);
                        *(f32x4*)(o + 4 * n) = r;
                    }
                }
            return;
        }
        const bool isq = pn < 2, isv = (!isq) && (wc >= 2);
        const int head = isq ? pn * 4 + wc : (wc & 1);
        const float* gam = (isq ? KIN(13) : KIN(14)) + j * 64 + 8 * fq;
        f32x4 gmv[2][2];
#pragma unroll
        for (int bj = 0; bj < 2; ++bj)
#pragma unroll
            for (int n = 0; n < 2; ++n) gmv[bj][n] = *(const f32x4*)(gam + 32 * bj + 4 * n);
        const float* ropec = (const float*)(ws + WS_ROPE) + 4 * fq;
        float* ncb = KOUT() + (size_t)T * D + (isv ? (size_t)32 * 2 * 256 * 128 : 0) + (size_t)j * 256 * 128 + head * 64 + 8 * fq;
#pragma unroll 1
        for (int am = 0; am < 2 * MT; ++am) {
            const int ai = am / MT, m = am % MT;
            const int row = rowb + ai * (TM / 2) + m * 16;
            const bool samp = row >= TP;
            f32x4 v[2][2];
#pragma unroll
            for (int a2 = 0; a2 < 2; ++a2)
#pragma unroll
                for (int m2 = 0; m2 < MT; ++m2)
                    if (a2 == ai && m2 == m) {
#pragma unroll
                        for (int bj = 0; bj < 2; ++bj)
#pragma unroll
                            for (int n = 0; n < 2; ++n) v[bj][n] = acc[a2][bj][m2][n];
                    }
            {
                float rs0 = 0.f;
#pragma unroll
                for (int a2 = 0; a2 < 2; ++a2)
#pragma unroll
                    for (int m2 = 0; m2 < MT; ++m2) rs0 = (a2 == ai && m2 == m) ? rsv[a2][m2] : rs0;
                const float* sw = sWb + (size_t)(row < TP ? 0 : 1 + ((row - TP) >> 10)) * 1792;
#pragma unroll
                for (int bj = 0; bj < 2; ++bj)
#pragma unroll
                    for (int n = 0; n < 2; ++n) v[bj][n] = v[bj][n] * rs0 + (cuni ? su[bj][n] : *(const f32x4*)(sw + 128 * bj + 4 * n));
            }
            if (!isv) {
                float ss = 0.f;
#pragma unroll
                for (int bj = 0; bj < 2; ++bj)
#pragma unroll
                    for (int n = 0; n < 2; ++n) ss += v[bj][n][0] * v[bj][n][0] + v[bj][n][1] * v[bj][n][1] + v[bj][n][2] * v[bj][n][2] + v[bj][n][3] * v[bj][n][3];
                ss += __shfl_xor(ss, 16); ss += __shfl_xor(ss, 32);
                const float rs = rsqrtf(ss * (1.f / 64.f) + 1e-6f);
#pragma unroll
                for (int bj = 0; bj < 2; ++bj)
#pragma unroll
                    for (int n = 0; n < 2; ++n) v[bj][n] = v[bj][n] * gmv[bj][n] * rs;
            }
            int b, l;
            if (samp) { const int tl = row - TP; b = tl >> 10; l = tl & 1023; } else { b = row >> 8; l = row & 255; }
            if (samp && !isv) {
#pragma unroll
                for (int bj = 0; bj < 2; ++bj) {
                    const f32x4 c4 = *(const f32x4*)(ropec + l * 32 + 16 * bj), s4 = *(const f32x4*)(ropec + 32768 + l * 32 + 16 * bj);
                    f32x4 a = v[bj][0], r;
                    r[0] = a[0] * c4[0] - a[1] * s4[0]; r[1] = a[0] * s4[0] + a[1] * c4[0]; r[2] = a[2] * c4[1] - a[3] * s4[1]; r[3] = a[2] * s4[1] + a[3] * c4[1];
                    v[bj][0] = r; a = v[bj][1];
                    r[0] = a[0] * c4[2] - a[1] * s4[2]; r[1] = a[0] * s4[2] + a[1] * c4[2]; r[2] = a[2] * c4[3] - a[3] * s4[3]; r[3] = a[2] * s4[3] + a[3] * c4[3];
                    v[bj][1] = r;
                }
            }
            if (!samp && !isq) {
                float* nc = ncb + ((size_t)(b * 2) * 256 + l) * 128;
#pragma unroll
                for (int bj = 0; bj < 2; ++bj) { *(f32x4*)(nc + 32 * bj) = v[bj][0]; *(f32x4*)(nc + 32 * bj + 4) = v[bj][1]; }
            }
            if (!isv) {
                const float sc = isq ? C2 : 1.f;
                bf16_t* dst;
                if (isq) dst = (bf16_t*)(ws + WS_Q) + (size_t)row * 512 + head * 64;
                else if (samp) dst = (bf16_t*)(ws + WS_KS) + (size_t)j * 4 * 2 * 1536 * 64 + ((size_t)(b * 2 + head) * 1536 + 512 + l) * 64;
                else dst = (bf16_t*)(ws + WS_KP) + ((size_t)(b * 2 + head) * 256 + l) * 64;
#pragma unroll
                for (int bj = 0; bj < 2; ++bj) { const f32x4 a = v[bj][0] * sc, c = v[bj][1] * sc; u32x4 w; w.x = cvt_pk_bf16(a[0], a[1]); w.y = cvt_pk_bf16(a[2], a[3]); w.z = cvt_pk_bf16(c[0], c[1]); w.w = cvt_pk_bf16(c[2], c[3]);
                    *(u32x4*)(dst + 32 * bj + 8 * fq) = w; }
            } else {
                bf16_t* vt; size_t vp;
                if (samp) { vt = (bf16_t*)(ws + WS_VST) + (size_t)j * 4 * 2 * 64 * 1536 + (size_t)(b * 2 + head) * 64 * 1536 + 512 + l; vp = 1536; }
                else { vt = (bf16_t*)(ws + WS_VPT) + (size_t)(b * 2 + head) * 64 * 256 + l; vp = 256; }
#pragma unroll
                for (int bj = 0; bj < 2; ++bj)
#pragma unroll
                    for (int n = 0; n < 2; ++n)
#pragma unroll
                        for (int jj = 0; jj < 4; ++jj) vt[(size_t)(32 * bj + 8 * fq + 4 * n + jj) * vp] = f2bf(v[bj][n][jj]);
            }
        }
    }
};

template <int TM> struct EpiOddIn {
    bf16_t* FTp; bf16_t* FTs; bf16_t* U; float* V; const float* rss; const float* sW;
    __device__ __forceinline__ void operator()(ACCREF(TM), const Unit& u, int wr, int wc, int fr, int fq) const {
        const int pn = u.pn, rowb = u.pm * TM + wr * (TM / 4) + fr;
        constexpr int MT = TM / 64;
        const int tr0 = u.pm * TM, c_lo = tr0 < TP ? 0 : 1 + ((tr0 - TP) >> 10), c_hi = (tr0 + TM - 1) < TP ? 0 : 1 + ((tr0 + TM - 1 - TP) >> 10);
        const float* swb = sW + pn * 256 + wc * 32 + fq * 8;
        f32x4 su[2][2];
#pragma unroll
        for (int bj = 0; bj < 2; ++bj)
#pragma unroll
            for (int n = 0; n < 2; ++n) su[bj][n] = *(const f32x4*)(swb + (size_t)c_lo * 2048 + 128 * bj + 4 * n);
        float rsv[2][MT];
#pragma unroll
        for (int ai = 0; ai < 2; ++ai)
#pragma unroll
            for (int m = 0; m < MT; ++m) rsv[ai][m] = rss[rowb + ai * (TM / 2) + m * 16];
#pragma unroll
        for (int ai = 0; ai < 2; ++ai)
#pragma unroll
            for (int m = 0; m < MT; ++m) {
                const int row = rowb + ai * (TM / 2) + m * 16;
                const float rs = rsqrtf(rsv[ai][m] * (1.f / 1024.f) + 1e-6f);
                f32x4 vv[2][2];
                if (c_lo == c_hi) {
#pragma unroll
                    for (int bj = 0; bj < 2; ++bj)
#pragma unroll
                        for (int n = 0; n < 2; ++n) vv[bj][n] = acc[ai][bj][m][n] * rs + su[bj][n];
                } else {
                    const float* sw = swb + (size_t)(row < TP ? 0 : 1 + ((row - TP) >> 10)) * 2048;
#pragma unroll
                    for (int bj = 0; bj < 2; ++bj)
#pragma unroll
                        for (int n = 0; n < 2; ++n) vv[bj][n] = acc[ai][bj][m][n] * rs + *(const f32x4*)(sw + 128 * bj + 4 * n);
                }
                if (pn < 4) {
                    const int isS = pn >> 1;
                    bf16_t* dst; size_t pitch;
                    if (row < TP) { const int b = row >> 8, l = row & 255; dst = FTp + (size_t)b * 512 * 512 + isS * 256 + l; pitch = 512; }
                    else { const int tl = row - TP, b = tl >> 10, l = tl & 1023; dst = FTs + (size_t)b * 512 * 2048 + isS * 1024 + l; pitch = 2048; }
#pragma unroll
                    for (int bj = 0; bj < 2; ++bj)
#pragma unroll
                        for (int n = 0; n < 2; ++n)
#pragma unroll
                            for (int j = 0; j < 4; ++j) { const int nf = (pn & 1) * 256 + 128 * bj + 32 * wc + 8 * fq + 4 * n + j; dst[(size_t)nf * pitch] = f2bf(vv[bj][n][j]); }
                } else if (pn < 6) {
#pragma unroll
                    for (int bj = 0; bj < 2; ++bj) { const f32x4 a = vv[bj][0], c = vv[bj][1]; u32x4 w; w.x = cvt_pk_bf16(a[0], a[1]); w.y = cvt_pk_bf16(a[2], a[3]); w.z = cvt_pk_bf16(c[0], c[1]); w.w = cvt_pk_bf16(c[2], c[3]);
                        *(u32x4*)(U + (size_t)row * 512 + (pn - 4) * 256 + 128 * bj + 32 * wc + 8 * fq) = w; }
                } else {
#pragma unroll
                    for (int bj = 0; bj < 2; ++bj)
#pragma unroll
                        for (int n = 0; n < 2; ++n) *(f32x4*)(V + (size_t)row * 512 + (pn - 6) * 256 + 128 * bj + 32 * wc + 8 * fq + 4 * n) = vv[bj][n];
                }
            }
    }
};

struct EpiFourier {
    bf16_t* MIX; int tok0, L;
    __device__ __forceinline__ void operator()(ACCREF(256), const Unit& u, int wr, int wc, int fr, int fq) const {
        const int b = u.pn >> 1, nb = (u.pn & 1) * 256 + 32 * wc + 8 * fq;
#pragma unroll
        for (int ai = 0; ai < 2; ++ai)
#pragma unroll
            for (int m = 0; m < 4; ++m) {
                const int lp = u.pm * 256 + wr * 64 + fr + ai * 128 + m * 16;
#pragma unroll
                for (int bj = 0; bj < 2; ++bj) { const f32x4 a = acc[ai][bj][m][0], c = acc[ai][bj][m][1]; u32x4 w; w.x = cvt_pk_bf16(a[0], a[1]); w.y = cvt_pk_bf16(a[2], a[3]); w.z = cvt_pk_bf16(c[0], c[1]); w.w = cvt_pk_bf16(c[2], c[3]);
                    *(u32x4*)(MIX + (size_t)(tok0 + b * L + lp) * D + nb + 128 * bj) = w; }
            }
    }
};

#define XB_TMO      128
#define XB_XCNT(j)  (256  + 64 * (j))
#define XB_XSUB(j)  (1280 + 64 * (j))
#define XB_XGEN(j)  (2304 + 64 * (j))
#define XB_TOP      3328
#define XB_TOPGEN   3392
#define XCD_BAR_WORDS 3456
#define XB_SPIN_CAP (1u << 20)
__device__ __forceinline__ unsigned xb_ld(unsigned* p)              { return __hip_atomic_load(p, __ATOMIC_RELAXED, __HIP_MEMORY_SCOPE_AGENT); }
__device__ __forceinline__ unsigned xb_add(unsigned* p, unsigned v) { return __hip_atomic_fetch_add(p, v, __ATOMIC_RELAXED, __HIP_MEMORY_SCOPE_AGENT); }
__device__ __forceinline__ unsigned xb_xcc_id() { return (unsigned)__builtin_amdgcn_s_getreg((3 << 11) | 20) & 0xFu; }
#define XB_SPIN(cond, bar) do { unsigned _sp = 0; while (cond) { __builtin_amdgcn_s_sleep(1); \
    if ((++_sp & 255u) == 0u) { if (xb_ld(&(bar)[XB_TMO])) break; if (_sp > XB_SPIN_CAP) { atomicAdd(&(bar)[XB_TMO], 1u); break; } } } } while (0)
__device__ __forceinline__ void xcd_barrier_complete(unsigned* bar, unsigned x, unsigned& nloc, unsigned& nx) {
    const unsigned G = gridDim.x;
    unsigned sum, cnt, mine, sp = 0u;
    for (;;) {
        sum = 0u; cnt = 0u; mine = 0u;
#pragma unroll
        for (unsigned j = 0; j < 16; ++j) { const unsigned c = xb_ld(&bar[XB_XCNT(j)]); sum += c; cnt += (c > 0u) ? 1u : 0u; mine = (j == x) ? c : mine; }
        if (sum == G) break;
        __builtin_amdgcn_s_sleep(1);
        if ((++sp & 255u) == 0u) { if (xb_ld(&bar[XB_TMO])) break; if (sp > XB_SPIN_CAP) { atomicAdd(&bar[XB_TMO], 1u); break; } }
    }
    nloc = mine > 0u ? mine : 1u; nx = cnt > 0u ? cnt : 1u;
}
__device__ __noinline__ void xcd_barrier(unsigned* bar, volatile LAS unsigned* st) {
    asm volatile("s_waitcnt vmcnt(0)" ::: "memory");
    __syncthreads();
    if (threadIdx.x == 0) {
        const unsigned x = xb_xcc_id();
        __builtin_amdgcn_s_waitcnt(0);
        unsigned nloc = st[0], nx = st[1];
        if (nloc == 0u) { xcd_barrier_complete(bar, x, nloc, nx); st[0] = nloc; st[1] = nx; }
        const unsigned old = xb_add(&bar[XB_XSUB(x)], 1u);
        const unsigned gen = old / nloc;
        if (old + 1u == (gen + 1u) * nloc) {
            __builtin_amdgcn_fence(__ATOMIC_RELEASE, "agent");
            asm volatile("s_waitcnt vmcnt(0)" ::: "memory");
            const unsigned og = xb_add(&bar[XB_TOP], 1u);
            const unsigned tg = og / nx;
            if (og + 1u == (tg + 1u) * nx) xb_add(&bar[XB_TOPGEN], 1u);
            else XB_SPIN(xb_ld(&bar[XB_TOPGEN]) == tg, bar);
            __builtin_amdgcn_fence(__ATOMIC_ACQUIRE, "agent");
            xb_add(&bar[XB_XGEN(x)], 1u);
            asm volatile("s_waitcnt vmcnt(0)" ::: "memory");
        } else {
            __builtin_amdgcn_fence(__ATOMIC_ACQUIRE, "agent");
            XB_SPIN(xb_ld(&bar[XB_XGEN(x)]) == gen, bar);
            asm volatile("s_waitcnt vmcnt(0)" ::: "memory");
        }
    }
    __syncthreads();
}

struct TrItem { const float* src; bf16_t* dst; int Nsrc, K; };
__device__ __forceinline__ TrItem tr_decode(const Params* kp, int it) {
    constexpr int I_F1 = 8 * 16 * 176, I_F2 = 8 * 44 * 32, I_EI = 2 * 16 * 56, I_EO = 2 * 16 * 32, I_OI = 2 * 16 * 32;
    unsigned char* ws = kp->ws;
    TrItem t; int r = it;
    if (r < I_F1) { const int mat = r / (16 * 176), rr = r % (16 * 176), kb = rr / 176, n0 = (rr % 176) * 32;
        const int pn = n0 >> 8, bj = (n0 >> 7) & 1, q = n0 & 127, src = bj * FFN + pn * 128 + q;
        t.Nsrc = 5632; t.K = D; t.src = kp->in[9] + (size_t)mat * D * 5632 + (size_t)(kb * 64) * 5632 + src; t.dst = (bf16_t*)(ws + WS_WF1) + ((size_t)mat * 5632 + n0) * D + kb * 64; return t; }
    r -= I_F1;
    if (r < I_F2) { const int mat = r / (44 * 32), rr = r % (44 * 32), kb = rr / 32, n0 = (rr % 32) * 32;
        t.Nsrc = D; t.K = FFN; t.src = kp->in[10] + (size_t)mat * FFN * D + (size_t)(kb * 64) * D + n0; t.dst = (bf16_t*)(ws + WS_WF2) + ((size_t)mat * D + n0) * FFN + kb * 64; return t; }
    r -= I_F2;
    if (r < I_EI) { const int mat = r / (16 * 56), rr = r % (16 * 56), kb = rr / 56, n0 = (rr % 56) * 32;
        const int pn = n0 >> 8, bj = (n0 >> 7) & 1, wc = (n0 >> 5) & 3; int src;
        if (pn < 2) src = (pn * 4 + wc) * 64 + 32 * bj;
        else if (pn == 2) src = (wc < 2 ? 512 + wc * 64 : 640 + (wc - 2) * 64) + 32 * bj;
        else src = 768 + bj * 512 + (pn - 3) * 128 + 32 * wc;
        t.Nsrc = 1792; t.K = D; t.src = kp->in[11] + (size_t)mat * D * 1792 + (size_t)(kb * 64) * 1792 + src; t.dst = (bf16_t*)(ws + WS_WEI) + ((size_t)mat * 1792 + n0) * D + kb * 64; return t; }
    r -= I_EI;
    if (r < I_EO) { const int mat = r / (16 * 32), rr = r % (16 * 32), kb = rr / 32, n0 = (rr % 32) * 32;
        t.Nsrc = D; t.K = D; t.src = kp->in[12] + (size_t)mat * D * D + (size_t)(kb * 64) * D + n0; t.dst = (bf16_t*)(ws + WS_WEO) + ((size_t)mat * D + n0) * D + kb * 64; return t; }
    r -= I_EO;
    if (r < I_OI) { const int mat = r / (16 * 32), rr = r % (16 * 32), kb = rr / 32, n0 = (rr % 32) * 32;
        t.Nsrc = 1536; t.K = D; t.src = kp->in[19] + (size_t)mat * D * 1536 + (size_t)(kb * 64) * 1536 + 512 + n0; t.dst = (bf16_t*)(ws + WS_WOI) + ((size_t)mat * 2048 + 1024 + n0) * D + kb * 64; return t; }
    r -= I_OI;
    { const int mat = r / (16 * 32), rr = r % (16 * 32), kb = rr / 32, n0 = (rr % 32) * 32;
        t.Nsrc = D; t.K = D; t.src = kp->in[20] + (size_t)mat * D * D + (size_t)(kb * 64) * D + n0; t.dst = (bf16_t*)(ws + WS_WOO) + ((size_t)mat * D + n0) * D + kb * 64; return t; }
}
__device__ __noinline__ void pro_a(const Params* kp, unsigned char* lds, int G) {
    const int tid = threadIdx.x, lane = tid & 63, wave = tid >> 6;
    float* scr = (float*)(lds + wave * 8704);
    const int gw = blockIdx.x * 8 + wave, NGW = G * 8;
    constexpr int TOT = 8 * 16 * 176 + 8 * 44 * 32 + 2 * 16 * 56 + 3 * 2 * 16 * 32;
    if (gw >= TOT) return;
    const int lr = lane >> 5, lc = lane & 31;
    TrItem cur = tr_decode(kp, gw);
    float r[32];
#pragma unroll
    for (int i = 0; i < 32; ++i) r[i] = cur.src[(size_t)(2 * i + lr) * cur.Nsrc + lc];
    for (int it = gw; it < TOT; it += NGW) {
        const bool has_next = it + NGW < TOT;
        TrItem nxt = cur; if (has_next) nxt = tr_decode(kp, it + NGW);
#pragma unroll
        for (int i = 0; i < 32; ++i) scr[(2 * i + lr) * 33 + lc] = r[i];
        __builtin_amdgcn_fence(__ATOMIC_RELEASE, "wavefront"); __builtin_amdgcn_wave_barrier();
        if (has_next) {
#pragma unroll
            for (int i = 0; i < 32; ++i) r[i] = nxt.src[(size_t)(2 * i + lr) * nxt.Nsrc + lc];
        }
        const int c = lane & 7;
#pragma unroll
        for (int j = 0; j < 4; ++j) { const int n = (lane >> 3) + 8 * j; const float* sp = scr + (8 * c) * 33 + n;
            u32x4 o; o.x = cvt_pk_bf16(sp[0 * 33], sp[1 * 33]); o.y = cvt_pk_bf16(sp[2 * 33], sp[3 * 33]); o.z = cvt_pk_bf16(sp[4 * 33], sp[5 * 33]); o.w = cvt_pk_bf16(sp[6 * 33], sp[7 * 33]);
            *(u32x4*)(cur.dst + (size_t)n * cur.K + 8 * c) = o; }
        __builtin_amdgcn_fence(__ATOMIC_RELEASE, "wavefront"); __builtin_amdgcn_wave_barrier();
        cur = nxt;
    }
}
__device__ __noinline__ void pro_b(const Params* kp, unsigned char* lds, int G) {
    const int tid = threadIdx.x, lane = tid & 63, wave = tid >> 6;
    unsigned char* ws = kp->ws;
    {
        float* Wt = (float*)lds;
        float* cs = Wt + 32 * 132; float* sn = cs + 128;
        if (tid < 128) { float sv, cv; sincospif((float)tid * (1.f / 64.f), &sv, &cv); cs[tid] = cv * 0.08838834764831845f; sn[tid] = sv * 0.08838834764831845f; }
        for (int item = blockIdx.x; item < 256; item += G) {
            const int j = item >> 7, g = (item >> 5) & 3, k0 = (item & 31) * 32;
            const float* W = kp->in[19] + (size_t)j * D * 1536;
            for (int e = tid; e < 32 * 128; e += 512) { const int kk = e >> 7, c = e & 127; Wt[kk * 132 + c] = W[(size_t)(k0 + kk) * 1536 + g * 128 + c]; }
            __syncthreads();
            const int cp = tid & 127, kg = tid >> 7;
            float aC[8], aS[8];
#pragma unroll
            for (int i = 0; i < 8; ++i) { aC[i] = 0.f; aS[i] = 0.f; }
            for (int c = 0; c < 128; c += 4) {
                float cv[4], sv[4];
#pragma unroll
                for (int q = 0; q < 4; ++q) { const int idx = ((c + q) * cp) & 127; cv[q] = cs[idx]; sv[q] = sn[idx]; }
#pragma unroll
                for (int i = 0; i < 8; ++i) { const f32x4 w = *(const f32x4*)(Wt + (kg * 8 + i) * 132 + c);
                    aC[i] += w[0] * cv[0] + w[1] * cv[1] + w[2] * cv[2] + w[3] * cv[3]; aS[i] += w[0] * sv[0] + w[1] * sv[1] + w[2] * sv[2] + w[3] * sv[3]; }
            }
            bf16_t* oc = (bf16_t*)(ws + WS_WOI) + ((size_t)j * 2048 + g * 128 + cp) * D + k0 + kg * 8;
            bf16_t* os = oc + (size_t)512 * D;
            u32x4 w;
            w.x = cvt_pk_bf16(aC[0], aC[1]); w.y = cvt_pk_bf16(aC[2], aC[3]); w.z = cvt_pk_bf16(aC[4], aC[5]); w.w = cvt_pk_bf16(aC[6], aC[7]); *(u32x4*)oc = w;
            w.x = cvt_pk_bf16(aS[0], aS[1]); w.y = cvt_pk_bf16(aS[2], aS[3]); w.z = cvt_pk_bf16(aS[4], aS[5]); w.w = cvt_pk_bf16(aS[6], aS[7]); *(u32x4*)os = w;
            __syncthreads();
        }
    }
    (void)lane; (void)wave; (void)ws;
}
__device__ __noinline__ void pro_c(const Params* kp, unsigned char* lds, int G) {
    const int tid = threadIdx.x, lane = tid & 63, wave = tid >> 6;
    unsigned char* ws = kp->ws;
    {
        const int gt = blockIdx.x * 512 + tid, NGT = G * 512;
        for (int it = gt; it < (256 * 512 + 1024 * 2048) / 8; it += NGT) {
            int e = it * 8; int L; bf16_t* dst;
            if (e < 256 * 512) { L = 256; dst = (bf16_t*)(ws + WS_D256); } else { e -= 256 * 512; L = 1024; dst = (bf16_t*)(ws + WS_D1024); }
            const int lp = e / (2 * L), cc = e % (2 * L), isS = cc >= L, l0 = cc - (isS ? L : 0);
            const float nrm = (L == 256) ? 0.0625f : 0.03125f;
            float v[8];
#pragma unroll
            for (int i = 0; i < 8; ++i) { const int mm = ((l0 + i) * lp) & (L - 1); float s, c; sincospif(2.f * (float)mm / (float)L, &s, &c); v[i] = isS ? -s * nrm : c * nrm; }
            u32x4 w; w.x = cvt_pk_bf16(v[0], v[1]); w.y = cvt_pk_bf16(v[2], v[3]); w.z = cvt_pk_bf16(v[4], v[5]); w.w = cvt_pk_bf16(v[6], v[7]);
            *(u32x4*)(dst + e) = w;
        }
        for (int it = gt; it < 12 * T; it += NGT) ((float*)(ws + WS_RSS))[it] = 0.f;
        for (int it = gt; it < 1024 * 32; it += NGT) {
            const int l = it >> 5, i = it & 31, f = i & 15;
            const float pos = (float)((i < 16) ? (l >> 6) : (l & 63));
            const float invf = 1.0f / powf(10000.f, (float)(2 * f) / 32.f);
            const float ang = pos * invf;
            ((float*)(ws + WS_ROPE))[it] = cosf(ang); ((float*)(ws + WS_ROPE))[32768 + it] = sinf(ang);
        }
        for (int it = gt; it < 4 * 2 * 512 * 128; it += NGT) {
            const int d = it & 63, kvh = (it >> 6) & 1, s = (it >> 7) & 511, j = (it >> 16) & 1, b = it >> 17;
            ((bf16_t*)(ws + WS_KS))[((size_t)((j * 4 + b) * 2 + kvh) * 1536 + s) * 64 + d] = f2bf(kp->in[2][it]);
            ((bf16_t*)(ws + WS_VST))[((size_t)((j * 4 + b) * 2 + kvh) * 64 + d) * 1536 + s] = f2bf(kp->in[3][it]);
        }
    }
    (void)lane; (void)wave; (void)ws;
}
__device__ __noinline__ void pro_d(const Params* kp, unsigned char* lds, int G) {
    const int tid = threadIdx.x;
    unsigned char* ws = kp->ws;
    float* sl = (float*)lds;
    float* red = sl + 5 * 1024;
    for (int e = tid; e < 5 * 1024; e += 512) { const int c = e >> 10, k = e & 1023; const float x = (c == 0) ? kp->in[5][k] : kp->in[4][(c - 1) * 1024 + k]; sl[e] = siluf_(x); }
    __syncthreads();
    for (int item = blockIdx.x; item < 4 * 144; item += G) {
        const int layer = item / 144, c0 = (item % 144) * 64;
        const int cl = tid & 63, kq = tid >> 6;
        const float* W = kp->in[6] + (size_t)layer * D * 9216 + (size_t)(kq * 128) * 9216 + c0 + cl;
        const float* s0 = sl + kq * 128;
        float a0 = 0.f, a1 = 0.f, a2 = 0.f, a3 = 0.f, a4 = 0.f;
#pragma unroll 1
        for (int kb = 0; kb < 128; kb += 32) {
            float w[32];
#pragma unroll
            for (int i = 0; i < 32; ++i) w[i] = W[(size_t)(kb + i) * 9216];
#pragma unroll
            for (int i = 0; i < 32; ++i) { const int k = kb + i; a0 += s0[k] * w[i]; a1 += s0[1024 + k] * w[i]; a2 += s0[2048 + k] * w[i]; a3 += s0[3072 + k] * w[i]; a4 += s0[4096 + k] * w[i]; }
        }
        red[(kq * 5 + 0) * 64 + cl] = a0; red[(kq * 5 + 1) * 64 + cl] = a1; red[(kq * 5 + 2) * 64 + cl] = a2; red[(kq * 5 + 3) * 64 + cl] = a3; red[(kq * 5 + 4) * 64 + cl] = a4;
        __syncthreads();
        if (tid < 5 * 64) { const int c = tid >> 6, cc = tid & 63;
            float v = kp->in[7][layer * 9216 + c0 + cc];
#pragma unroll
            for (int q = 0; q < 8; ++q) v += red[(q * 5 + c) * 64 + cc];
            ((float*)(ws + WS_MOD))[((size_t)layer * 5 + c) * 9216 + c0 + cc] = v; }
        __syncthreads();
    }
}
__device__ __forceinline__ void prologue(const Params* kp, unsigned char* lds, int G) {
    if (blockIdx.x & 1) { pro_b(kp, lds, G); __syncthreads(); pro_c(kp, lds, G); __syncthreads(); pro_d(kp, lds, G); __syncthreads(); pro_a(kp, lds, G); }
    else { pro_a(kp, lds, G); __syncthreads(); pro_b(kp, lds, G); __syncthreads(); pro_c(kp, lds, G); __syncthreads(); pro_d(kp, lds, G); }
}

__device__ __noinline__ void pre_phase(const Params* kp, int G) {
    const int tid = threadIdx.x, lane = tid & 63, gw = blockIdx.x * 8 + (tid >> 6), NGW = G * 8;
    unsigned char* ws = kp->ws;
    const float* MOD = (const float*)(ws + WS_MOD);
    for (int t = gw; t < T; t += NGW) {
        const float* xr = (t < TP) ? kp->in[0] + (size_t)t * D : kp->in[1] + (size_t)(t - TP) * D;
        const int cond = (t < TP) ? 0 : 1 + ((t - TP) >> 10);
        const float* sc = MOD + (size_t)cond * 9216 + 1024;
        f32x4 v[4]; float ss = 0.f;
#pragma unroll
        for (int j = 0; j < 4; ++j) { v[j] = *(const f32x4*)(xr + lane * 4 + 256 * j); ss += v[j][0] * v[j][0] + v[j][1] * v[j][1] + v[j][2] * v[j][2] + v[j][3] * v[j][3]; }
        ss = wave_sum(ss);
        if (lane == 0) ((float*)(ws + WS_RSS))[t] = ss;
#pragma unroll
        for (int j = 0; j < 4; ++j) {
            const int c = lane * 4 + 256 * j;
            const f32x4 o = v[j] * *(const f32x4*)(kp->in[8] + c) * (*(const f32x4*)(sc + c) + 1.f);
            u32x2 w; w.x = cvt_pk_bf16(o[0], o[1]); w.y = cvt_pk_bf16(o[2], o[3]);
            *(u32x2*)((bf16_t*)(ws + WS_H) + (size_t)t * D + c) = w;
        }
    }
    for (int e = blockIdx.x * 512 + tid; e < 12 * 5 * 1024; e += G * 512) {
        const int k = e & 1023, c = (e >> 10) % 5, sidx = e / 5120, layer = sidx / 3, sub = sidx % 3;
        ((float*)(ws + WS_GS))[e] = kp->in[8][sidx * 1024 + k] * (1.f + MOD[((size_t)layer * 5 + c) * 9216 + (3 * sub + 1) * 1024 + k]);
    }
}

__device__ __noinline__ void shiftw_phase(const Params* kp, int G) {
    const int tid = threadIdx.x, lane = tid & 63, fr = lane & 15, fq = lane >> 4, gw = blockIdx.x * 8 + (tid >> 6), NGW = G * 8;
    unsigned char* ws = kp->ws;
    const float* MOD = (const float*)(ws + WS_MOD);
    constexpr int C_F1 = 8 * 352, C_EI = 2 * 112, C_OI = 2 * 128;
    for (int ck = gw; ck < C_F1 + C_EI + C_OI; ck += NGW) {
        const bf16_t* wrow; const float* shift; float* dst; int N;
        if (ck < C_F1) { const int mat = ck / 352, n0 = (ck % 352) * 16, layer = mat >> 1, sub = (mat & 1) * 2;
            wrow = (const bf16_t*)(ws + WS_WF1) + ((size_t)mat * 5632 + n0) * D; shift = MOD + (size_t)layer * 5 * 9216 + (3 * sub) * 1024; dst = (float*)(ws + WS_SW) + (size_t)mat * 5 * 5632 + n0; N = 5632; }
        else if (ck < C_F1 + C_EI) { const int q = ck - C_F1, jj = q / 112, n0 = (q % 112) * 16;
            wrow = (const bf16_t*)(ws + WS_WEI) + ((size_t)jj * 1792 + n0) * D; shift = MOD + (size_t)(2 * jj) * 5 * 9216 + 3 * 1024; dst = (float*)(ws + WS_SW) + SW_EI + (size_t)jj * 5 * 1792 + n0; N = 1792; }
        else { const int q = ck - C_F1 - C_EI, jj = q / 128, n0 = (q % 128) * 16;
            wrow = (const bf16_t*)(ws + WS_WOI) + ((size_t)jj * 2048 + n0) * D; shift = MOD + (size_t)(2 * jj + 1) * 5 * 9216 + 3 * 1024; dst = (float*)(ws + WS_SW) + SW_OI + (size_t)jj * 5 * 2048 + n0; N = 2048; }
        const bf16_t* wp = wrow + (size_t)fr * D + fq * 8;
        const float* sp = shift + (size_t)(fr < 5 ? fr : 4) * 9216 + fq * 8;
        const float msk = fr < 5 ? 1.f : 0.f;
        f32x4 acc = (f32x4){0.f, 0.f, 0.f, 0.f};
#pragma unroll 1
        for (int kb = 0; kb < 32; kb += 4) {
            u32x4 bw[4]; f32x4 s0[4], s1[4];
#pragma unroll
            for (int i = 0; i < 4; ++i) { bw[i] = *(const u32x4*)(wp + (kb + i) * 32); s0[i] = *(const f32x4*)(sp + (kb + i) * 32); s1[i] = *(const f32x4*)(sp + (kb + i) * 32 + 4); }
#pragma unroll
            for (int i = 0; i < 4; ++i) {
                const f32x4 a0 = s0[i] * msk, a1 = s1[i] * msk;
                u32x4 aw; aw.x = cvt_pk_bf16(a0[0], a0[1]); aw.y = cvt_pk_bf16(a0[2], a0[3]); aw.z = cvt_pk_bf16(a1[0], a1[1]); aw.w = cvt_pk_bf16(a1[2], a1[3]);
                acc = __builtin_amdgcn_mfma_f32_16x16x32_bf16(__builtin_bit_cast(bf16x8, aw), __builtin_bit_cast(bf16x8, bw[i]), acc, 0, 0, 0);
            }
        }
        if (fq == 0) { dst[fr] = acc[0]; dst[(size_t)N + fr] = acc[1]; dst[(size_t)2 * N + fr] = acc[2]; dst[(size_t)3 * N + fr] = acc[3]; }
        else if (fq == 1) dst[(size_t)4 * N + fr] = acc[0];
    }
}

__device__ __noinline__ void attn_unit(const bf16_t* Q, int qrow0, int h, const bf16_t* Kb, const bf16_t* VT, int Lk, bf16_t* O, unsigned char* lds) {
    constexpr int KB = 18432, BUF = 35840, VP = 272;
    const int tid = threadIdx.x, wave = tid >> 6, lane = tid & 63, fr = lane & 15, fq = lane >> 4;
    const bf16_t* qp = Q + (size_t)(qrow0 + wave * 16 + fr) * 512 + h * 64 + fq * 8;
    const bf16x8 qf0 = *(const bf16x8*)qp, qf1 = *(const bf16x8*)(qp + 32);
    f32x4 o[4];
#pragma unroll
    for (int i = 0; i < 4; ++i) o[i] = (f32x4){0.f, 0.f, 0.f, 0.f};
    float mrun = -1e30f, lrun = 0.f;
    const int srow = tid >> 3, sch = tid & 7;
    const bf16_t* kg = Kb + srow * 64 + sch * 8;
    const bf16_t* vg = VT + (size_t)srow * Lk + sch * 8;
    const unsigned slk = srow * 144 + sch * 16, slv = KB + srow * VP + sch * 16;
    u32x4 kr0 = *(const u32x4*)kg, kr1 = *(const u32x4*)(kg + 64 * 64), vr0 = *(const u32x4*)vg, vr1 = *(const u32x4*)(vg + 64);
    *(u32x4*)(lds + slk) = kr0; *(u32x4*)(lds + slk + 64 * 144) = kr1; *(u32x4*)(lds + slv) = vr0; *(u32x4*)(lds + slv + 128) = vr1;
    __syncthreads();
    const int nt = Lk >> 7;
    for (int t = 0; t < nt; ++t) {
        const int cur = t & 1;
        if (t + 1 < nt) { const bf16_t* kn = kg + (size_t)(t + 1) * 128 * 64; const bf16_t* vn = vg + (t + 1) * 128;
            kr0 = *(const u32x4*)kn; kr1 = *(const u32x4*)(kn + 64 * 64); vr0 = *(const u32x4*)vn; vr1 = *(const u32x4*)(vn + 64); }
        const unsigned char* Kt = lds + cur * BUF; const unsigned char* Vt = Kt + KB;
        f32x4 s[8];
#pragma unroll
        for (int u = 0; u < 8; ++u) {
            const int krow = (u >> 1) * 32 + 8 * (fr >> 2) + 4 * (u & 1) + (fr & 3);
            const bf16x8 a0 = *(const bf16x8*)(Kt + krow * 144 + fq * 16), a1 = *(const bf16x8*)(Kt + krow * 144 + 64 + fq * 16);
            s[u] = __builtin_amdgcn_mfma_f32_16x16x32_bf16(a0, qf0, (f32x4){0.f, 0.f, 0.f, 0.f}, 0, 0, 0);
            s[u] = __builtin_amdgcn_mfma_f32_16x16x32_bf16(a1, qf1, s[u], 0, 0, 0);
        }
        float mx = s[0][0];
#pragma unroll
        for (int u = 0; u < 8; ++u)
#pragma unroll
            for (int j = 0; j < 4; ++j) mx = fmaxf(mx, s[u][j]);
        mx = fmaxf(mx, __shfl_xor(mx, 16)); mx = fmaxf(mx, __shfl_xor(mx, 32));
        const float mnew = fmaxf(mrun, mx), alpha = __builtin_amdgcn_exp2f(mrun - mnew); mrun = mnew;
        float ls = 0.f;
#pragma unroll
        for (int u = 0; u < 8; ++u)
#pragma unroll
            for (int j = 0; j < 4; ++j) { s[u][j] = __builtin_amdgcn_exp2f(s[u][j] - mnew); ls += s[u][j]; }
        lrun = lrun * alpha + ls;
#pragma unroll
        for (int i = 0; i < 4; ++i) o[i] = o[i] * alpha;
#pragma unroll
        for (int g2 = 0; g2 < 4; ++g2) {
            u32x4 pw; pw.x = cvt_pk_bf16(s[2 * g2][0], s[2 * g2][1]); pw.y = cvt_pk_bf16(s[2 * g2][2], s[2 * g2][3]); pw.z = cvt_pk_bf16(s[2 * g2 + 1][0], s[2 * g2 + 1][1]); pw.w = cvt_pk_bf16(s[2 * g2 + 1][2], s[2 * g2 + 1][3]);
            const bf16x8 pf = __builtin_bit_cast(bf16x8, pw);
#pragma unroll
            for (int dt = 0; dt < 4; ++dt) {
                const bf16x8 vf = *(const bf16x8*)(Vt + (dt * 16 + fr) * VP + g2 * 64 + fq * 16);
                o[dt] = __builtin_amdgcn_mfma_f32_16x16x32_bf16(vf, pf, o[dt], 0, 0, 0);
            }
        }
        if (t + 1 < nt) { unsigned char* nb = lds + (cur ^ 1) * BUF; *(u32x4*)(nb + slk) = kr0; *(u32x4*)(nb + slk + 64 * 144) = kr1; *(u32x4*)(nb + slv) = vr0; *(u32x4*)(nb + slv + 128) = vr1; }
        __syncthreads();
    }
    lrun += __shfl_xor(lrun, 16); lrun += __shfl_xor(lrun, 32);
    const float inv = 1.f / lrun;
    bf16_t* op = O + (size_t)(qrow0 + wave * 16 + fr) * D + h * 64 + fq * 4;
#pragma unroll
    for (int dt = 0; dt < 4; ++dt) { u32x2 w; w.x = cvt_pk_bf16(o[dt][0] * inv, o[dt][1] * inv); w.y = cvt_pk_bf16(o[dt][2] * inv, o[dt][3] * inv); *(u32x2*)(op + dt * 16) = w; }
}

#define GAS __attribute__((address_space(1)))
template <class P> __device__ __forceinline__ GAS P* uniform_ptr(P* p) {
    const unsigned long long v = (unsigned long long)p; const unsigned lo = __builtin_amdgcn_readfirstlane((unsigned)v), hi = __builtin_amdgcn_readfirstlane((unsigned)(v >> 32));
    return (GAS P*)(((unsigned long long)hi << 32) | lo);
}
__device__ __forceinline__ void conv_rows(GAS const float* glu, int u, int ch, float (&gv)[46]) {
    const int t0 = u * 16; int bs, be;
    if (t0 < TP) { bs = t0 & ~255; be = bs + 256; } else { bs = TP + ((t0 - TP) & ~1023); be = bs + 1024; }
#pragma unroll
    for (int r = 0; r < 46; ++r) {
        const int tr = t0 - 15 + r; const int trc = __builtin_amdgcn_readfirstlane(tr < bs ? bs : (tr >= be ? be - 1 : tr));
        GAS const float* rowp = glu + (size_t)trc * 512;
        gv[r] = rowp[(unsigned)ch];
    }
}
__device__ __forceinline__ void conv_phase(const float* glu_, const float* cw_, const float* cb, const float* cng, const float* cnb, bf16_t* MIX_, unsigned char* lds, int G_) {
    const int ch = threadIdx.x, lane = ch & 63, wave = ch >> 6;
    GAS const float* glu = uniform_ptr(glu_); GAS const float* cw = uniform_ptr(cw_); GAS bf16_t* MIX = uniform_ptr(MIX_); const int G = __builtin_amdgcn_readfirstlane(G_);
    float* tile = (float*)lds;
    float* stat = tile + 16 * 512;
    const float bias = cb[ch], g = cng[ch], b = cnb[ch];
    int u = blockIdx.x;
    if (u >= 768) return;
    for (; u < 768; u += G) {
        float gv[46];
        conv_rows(glu, u, ch, gv);
        const int t0 = u * 16; int bs, be;
        if (t0 < TP) { bs = t0 & ~255; be = bs + 256; } else { bs = TP + ((t0 - TP) & ~1023); be = bs + 1024; }
#pragma unroll
        for (int r = 0; r < 46; ++r) { const int tr = t0 - 15 + r; gv[r] = (tr >= bs && tr < be) ? gv[r] : 0.f; }
        float out[16];
#pragma unroll
        for (int i = 0; i < 16; ++i) out[i] = bias;
#pragma unroll
        for (int tap = 0; tap < 31; ++tap) {
            const float w = (cw + tap * 512)[(unsigned)ch];
#pragma unroll
            for (int i = 0; i < 16; ++i) out[i] += w * gv[i + tap];
        }
#pragma unroll
        for (int i = 0; i < 16; ++i) tile[i * 512 + ch] = out[i];
        __syncthreads();
#pragma unroll
        for (int tk = 0; tk < 2; ++tk) {
            const int tok = wave * 2 + tk;
            const f32x4 a = *(const f32x4*)(tile + tok * 512 + lane * 8), c = *(const f32x4*)(tile + tok * 512 + lane * 8 + 4);
            float s1 = a[0] + a[1] + a[2] + a[3] + c[0] + c[1] + c[2] + c[3];
            float s2 = a[0] * a[0] + a[1] * a[1] + a[2] * a[2] + a[3] * a[3] + c[0] * c[0] + c[1] * c[1] + c[2] * c[2] + c[3] * c[3];
#pragma unroll
            for (int o = 1; o < 64; o <<= 1) { s1 += __shfl_xor(s1, o); s2 += __shfl_xor(s2, o); }
            if (lane == 0) { const float mu = s1 * (1.f / 512.f), var = fmaxf(s2 * (1.f / 512.f) - mu * mu, 0.f); stat[tok * 2] = mu; stat[tok * 2 + 1] = rsqrtf(var + 1e-5f); }
        }
        __syncthreads();
#pragma unroll
        for (int i = 0; i < 16; ++i) {
            const float y = (out[i] - stat[2 * i]) * stat[2 * i + 1] * g + b;
            MIX[(size_t)(t0 + i) * D + 512 + ch] = f2bf(siluf_(y));
        }
        __syncthreads();
    }
}

__device__ __noinline__ void sgu_unit(const float* V, const bf16_t* U, int t0, int g, const float* sw  , const float* sb  ,
                                          const float* sng, const float* snb, bf16_t* MIX, unsigned char* lds) {
    const int tid = threadIdx.x, wave = tid >> 6, lane = tid & 63, fr = lane & 15, fq = lane >> 4;
    bf16_t* vT = (bf16_t*)lds;
    bf16_t* wS = vT + 128 * 136;
    float* st = (float*)(wS + 128 * 136);
#pragma unroll 1
    for (int hb = 0; hb < 2; ++hb) {
        f32x4 a[8], b[8];
#pragma unroll
        for (int i = 0; i < 8; ++i) { const float* vr = V + (size_t)(t0 + wave * 16 + hb * 8 + i) * 512 + lane * 8; a[i] = *(const f32x4*)vr; b[i] = *(const f32x4*)(vr + 4); }
        float s1[8], s2[8];
#pragma unroll
        for (int i = 0; i < 8; ++i) { s1[i] = a[i][0] + a[i][1] + a[i][2] + a[i][3] + b[i][0] + b[i][1] + b[i][2] + b[i][3];
            s2[i] = a[i][0] * a[i][0] + a[i][1] * a[i][1] + a[i][2] * a[i][2] + a[i][3] * a[i][3] + b[i][0] * b[i][0] + b[i][1] * b[i][1] + b[i][2] * b[i][2] + b[i][3] * b[i][3]; }
#pragma unroll
        for (int o = 1; o < 64; o <<= 1) {
#pragma unroll
            for (int i = 0; i < 8; ++i) { s1[i] += __shfl_xor(s1[i], o); s2[i] += __shfl_xor(s2[i], o); }
        }
#pragma unroll
        for (int i = 0; i < 8; ++i) if (lane == i) { const float mu = s1[i] * (1.f / 512.f), var = fmaxf(s2[i] * (1.f / 512.f) - mu * mu, 0.f); const int q = wave * 16 + hb * 8 + i; st[q * 2] = mu; st[q * 2 + 1] = rsqrtf(var + 1e-5f); }
    }
    for (int e = tid; e < 128 * 16; e += 512) { const int pp = e >> 4, q8 = (e & 15) * 8;
        const f32x4 a = *(const f32x4*)(sw + pp * 128 + q8), b = *(const f32x4*)(sw + pp * 128 + q8 + 4);
        u32x4 w; w.x = cvt_pk_bf16(a[0], a[1]); w.y = cvt_pk_bf16(a[2], a[3]); w.z = cvt_pk_bf16(b[0], b[1]); w.w = cvt_pk_bf16(b[2], b[3]);
        *(u32x4*)(wS + pp * 136 + q8) = w; }
    __syncthreads();
    for (int e = tid; e < 128 * 16; e += 512) { const int q = e & 127, c8 = (e >> 7) * 8;
        const float* vr = V + (size_t)(t0 + q) * 512 + g * 128 + c8;
        const f32x4 a = *(const f32x4*)vr, b = *(const f32x4*)(vr + 4);
        const float mu = st[q * 2], rs = st[q * 2 + 1];
        const f32x4 ga = *(const f32x4*)(sng + g * 128 + c8), gb = *(const f32x4*)(sng + g * 128 + c8 + 4), ba = *(const f32x4*)(snb + g * 128 + c8), bb = *(const f32x4*)(snb + g * 128 + c8 + 4);
        const f32x4 ya = (a - mu) * rs * ga + ba, yb = (b - mu) * rs * gb + bb;
#pragma unroll
        for (int i = 0; i < 4; ++i) { vT[(c8 + i) * 136 + q] = f2bf(ya[i]); vT[(c8 + 4 + i) * 136 + q] = f2bf(yb[i]); }
    }
    __syncthreads();
    f32x4 acc[8];
#pragma unroll
    for (int i = 0; i < 8; ++i) acc[i] = (f32x4){0.f, 0.f, 0.f, 0.f};
#pragma unroll
    for (int kk = 0; kk < 4; ++kk) {
        const bf16x8 bfr = *(const bf16x8*)(wS + (wave * 16 + fr) * 136 + kk * 32 + fq * 8);
#pragma unroll
        for (int ct = 0; ct < 8; ++ct) {
            const bf16x8 afr = *(const bf16x8*)(vT + (ct * 16 + fr) * 136 + kk * 32 + fq * 8);
            acc[ct] = __builtin_amdgcn_mfma_f32_16x16x32_bf16(afr, bfr, acc[ct], 0, 0, 0);
        }
    }
    const int pp = wave * 16 + fr; const float bias = sb[pp];
#pragma unroll
    for (int ct = 0; ct < 8; ++ct) {
        const int c = g * 128 + ct * 16 + fq * 4;
        const u32x2 uu = *(const u32x2*)(U + (size_t)(t0 + pp) * 512 + c);
        const float u0 = bf2f(uu.x & 0xffffu), u1 = bf2f(uu.x >> 16), u2 = bf2f(uu.y & 0xffffu), u3 = bf2f(uu.y >> 16);
        u32x2 w; w.x = cvt_pk_bf16(u0 * (acc[ct][0] + bias), u1 * (acc[ct][1] + bias)); w.y = cvt_pk_bf16(u2 * (acc[ct][2] + bias), u3 * (acc[ct][3] + bias));
        *(u32x2*)(MIX + (size_t)(t0 + pp) * D + 512 + c) = w;
    }
    __syncthreads();
}


__global__ void __launch_bounds__(512, 2) mega(Params p_unused) {
    extern __shared__ __attribute__((aligned(16))) unsigned char lds[];
    cg::grid_group grid = cg::this_grid();
    const int hi = kparams()->ph_hi;
    volatile LAS unsigned* bst = (volatile LAS unsigned*)((LAS unsigned char*)lds + 131072 + 64);
    if (threadIdx.x == 0) { bst[0] = 0u; bst[1] = 0u;
        if (hi - kparams()->ph_lo > 1) (void)xb_add(&((unsigned*)(KWS() + WS_BAR))[XB_XCNT(xb_xcc_id())], 1u); }
    __syncthreads();
    for (int ph = kparams()->ph_lo; ph < hi; ++ph) {
        const int G = gridDim.x;
        LAS unsigned char* ldsl = (LAS unsigned char*)lds;
        if (ph == 0) {
#ifndef NO_PRO
            for (int rp = 0; rp < DUPN(1); ++rp) { prologue((const Params*)kparams(), lds, G); __syncthreads(); }
#endif
        } else if (ph == 1) {
            if (blockIdx.x & 1) { shiftw_phase((const Params*)kparams(), G); pre_phase((const Params*)kparams(), G); }
            else { pre_phase((const Params*)kparams(), G); shiftw_phase((const Params*)kparams(), G); }
        } else {
            const int q = ph - 2, layer = q / 7, r = q % 7, j = layer >> 1;
            const int sub = (r < 2) ? 0 : (r < 5 ? 1 : 2), sidx = layer * 3 + sub;
            const bool first = (layer == 0 && sub == 0), lastsub = (layer == 3 && sub == 2);
            if (r == 0 || r == 5) {
#ifndef NO_F1
                unsigned char* ws = KWS();
                const int mat = layer * 2 + (sub >> 1);
                constexpr int M1 = 46 * 256;
                for (int rp = 0; rp < DUPN(4); ++rp) {
                    { pg8::Gemm g{(const bf16_t*)(ws + WS_H), (const bf16_t*)(ws + WS_WF1) + (size_t)mat * 5632 * D, M1, 5632, D}; pg8::StaticOrder S; S.init(M1, 5632, G, blockIdx.x, 256);
                      const EpiSwiglu<256> E{(bf16_t*)(ws + WS_HID), (const float*)(ws + WS_RSS) + (size_t)sidx * T, (const float*)(ws + WS_SW) + (size_t)mat * 5 * 5632, 0};
                      pg8::gemm_phase<256>(ldsl, g, S, E); }
                    { pg8::Gemm g{(const bf16_t*)(ws + WS_H) + (size_t)M1 * D, (const bf16_t*)(ws + WS_WF1) + (size_t)mat * 5632 * D, T - M1, 5632, D}; pg8::StaticOrder S; S.init(T - M1, 5632, G, G - 1 - (int)blockIdx.x, 128);
                      const EpiSwiglu<128> E{(bf16_t*)(ws + WS_HID), (const float*)(ws + WS_RSS) + (size_t)sidx * T, (const float*)(ws + WS_SW) + (size_t)mat * 5 * 5632, M1};
                      pg8::gemm_phase<128>(ldsl, g, S, E); }
                }
#endif
            } else if (r == 1 || r == 6 || r == 4) {
#ifndef NO_F2
                unsigned char* ws = KWS();
                const int mat = layer * 2 + (sub >> 1);
                pg8::Gemm g;
                if (r == 4) g = pg8::Gemm{(const bf16_t*)(ws + WS_MIX), (const bf16_t*)(ws + ((layer & 1) ? WS_WOO : WS_WEO)) + (size_t)j * D * D, T, D, D};
                else g = pg8::Gemm{(const bf16_t*)(ws + WS_HID), (const bf16_t*)(ws + WS_WF2) + (size_t)mat * D * FFN, T, D, FFN};
                pg8::StaticOrder S; S.init(T, D, G, blockIdx.x, GT);
                const EpiResid<GT> ER{layer, sub};
                pg8::gemm_phase<GT>(ldsl, g, S, ER);
#endif
            } else if ((layer & 1) == 0) {
                if (r == 2) {
#ifndef NO_EI
                    unsigned char* ws = KWS();
                    pg8::Gemm g{(const bf16_t*)(ws + WS_H), (const bf16_t*)(ws + WS_WEI) + (size_t)j * 1792 * D, T, 1792, D}; pg8::StaticOrder S; S.init(T, 1792, G, blockIdx.x, GT);
                    const EpiEvenIn<GT> E{j, sidx};
                    for (int rp = 0; rp < DUPN(8); ++rp) pg8::gemm_phase<GT>(ldsl, g, S, E);
#endif
                } else {
#ifndef NO_ATT
                    for (int rp = 0; rp < DUPN(16); ++rp) {
                    unsigned char* ws = KWS();
                    const bf16_t* Ks = (const bf16_t*)(ws + WS_KS) + (size_t)j * 4 * 2 * 1536 * 64; const bf16_t* VsT = (const bf16_t*)(ws + WS_VST) + (size_t)j * 4 * 2 * 64 * 1536;
                    bf16_t* MIX = (bf16_t*)(ws + WS_MIX);
                    for (int u = blockIdx.x; u < 768; u += G) {
                        if (u < 256) { const int b = u >> 6, h = (u >> 3) & 7, qt = u & 7, kvh = h >> 2;
                            attn_unit((const bf16_t*)(ws + WS_Q), TP + b * 1024 + qt * 128, h, Ks + (size_t)(b * 2 + kvh) * 1536 * 64, VsT + (size_t)(b * 2 + kvh) * 64 * 1536, 1536, MIX, lds);
                        } else { const int v = u - 256, b = v >> 4, h = (v >> 1) & 7, qt = v & 1, kvh = h >> 2;
                            attn_unit((const bf16_t*)(ws + WS_Q), b * 256 + qt * 128, h, (const bf16_t*)(ws + WS_KP) + (size_t)(b * 2 + kvh) * 256 * 64, (const bf16_t*)(ws + WS_VPT) + (size_t)(b * 2 + kvh) * 64 * 256, 256, MIX, lds); }
                    }
                    }
#endif
#ifndef NO_CONV
                    for (int rp = 0; rp < DUPN(32); ++rp) {
                    unsigned char* ws = KWS();
                    conv_phase((const float*)(ws + WS_GLU), KIN(15) + (size_t)j * 31 * 512, KIN(16) + j * 512, KIN(17) + j * 512, KIN(18) + j * 512, (bf16_t*)(ws + WS_MIX), lds, G);
                    }
#endif
                }
            } else {
                if (r == 2) {
#ifndef NO_OI
                    unsigned char* ws = KWS();
                    pg8::Gemm g{(const bf16_t*)(ws + WS_H), (const bf16_t*)(ws + WS_WOI) + (size_t)j * 2048 * D, T, 2048, D}; pg8::StaticOrder S; S.init(T, 2048, G, blockIdx.x, GT);
                    const EpiOddIn<GT> E{(bf16_t*)(ws + WS_FTP), (bf16_t*)(ws + WS_FTS), (bf16_t*)(ws + WS_U), (float*)(ws + WS_V), (const float*)(ws + WS_RSS) + (size_t)sidx * T, (const float*)(ws + WS_SW) + SW_OI + (size_t)j * 5 * 2048};
                    for (int rp = 0; rp < DUPN(8); ++rp) pg8::gemm_phase<GT>(ldsl, g, S, E);
#endif
                } else {
#ifndef NO_FOUR
                    for (int which = 0; which < 2 * DUPN(64); ++which) {
                        unsigned char* ws = KWS();
                        pg8::Gemm g; pg8::StaticOrder S; EpiFourier E;
                        if ((which & 1) == 0) { g = pg8::Gemm{(const bf16_t*)(ws + WS_D1024), (const bf16_t*)(ws + WS_FTS), 1024, 2048, 2048}; S.init(1024, 2048, G, blockIdx.x); E = EpiFourier{(bf16_t*)(ws + WS_MIX), TP, 1024}; }
                        else { g = pg8::Gemm{(const bf16_t*)(ws + WS_D256), (const bf16_t*)(ws + WS_FTP), 256, 16384, 512}; S.init(256, 16384, G, (blockIdx.x + G - (32 % G)) % G); E = EpiFourier{(bf16_t*)(ws + WS_MIX), 0, 256}; }
                        pg8::gemm_phase<256>(ldsl, g, S, E);
                    }
#endif
#ifndef NO_SGU
                    for (int rp = 0; rp < DUPN(128); ++rp) {
                    unsigned char* ws = KWS();
                    const bool g256 = (G == 256);
                    for (int u = g256 ? (blockIdx.x >= 32 ? 255 - (int)blockIdx.x : 384) : (int)blockIdx.x; u < 384; u += (g256 ? 224 : G)) {
                        const int ch = u >> 2, g = u & 3;
                        sgu_unit((const float*)(ws + WS_V), (const bf16_t*)(ws + WS_U), ch * 128, g, KIN(23) + ((size_t)j * 4 + g) * 128 * 128, KIN(24) + (j * 4 + g) * 128,
                                 KIN(21) + j * 512, KIN(22) + j * 512, (bf16_t*)(ws + WS_MIX), lds);
                    }
                    }
#endif
                }
            }
        }
        if (ph + 1 < hi) {
            unsigned* bar = (unsigned*)(KWS() + WS_BAR);
            if (hi > (1 << 20)) grid.sync();
            xcd_barrier(bar, bst); if (DUP_MASK & 256) xcd_barrier(bar, bst);
        }
    }
}

extern "C" void kernel_launch(void* const* d_in, const int* in_sizes, int n_in, void* d_out, int out_size, void* d_ws, size_t ws_size, hipStream_t stream) {
    static int grid = 0;
    if (grid == 0) {
        if (n_in != 25 || ws_size < WS_END) { fprintf(stderr, "kernel_launch: unexpected n_in %d / ws_size %zu\n", n_in, ws_size); grid = -1; return; }
        int dev = 0, cus = 0, per_cu = 0;
        hipGetDevice(&dev);
        hipDeviceGetAttribute(&cus, hipDeviceAttributeMultiprocessorCount, dev);
        if (hipFuncSetAttribute((const void*)mega, hipFuncAttributeMaxDynamicSharedMemorySize, LDS_BYTES) != hipSuccess) { fprintf(stderr, "kernel_launch: hipFuncSetAttribute failed\n"); grid = -1; return; }
        if (hipOccupancyMaxActiveBlocksPerMultiprocessor(&per_cu, (const void*)mega, 512, LDS_BYTES) != hipSuccess || per_cu < 1) { fprintf(stderr, "kernel_launch: occupancy query failed (%d)\n", per_cu); grid = -1; return; }
        grid = cus;
    }
    if (grid < 0) return;
    if (hipMemsetAsync((char*)d_ws + WS_BAR, 0, XCD_BAR_WORDS * 4, stream) != hipSuccess) { fprintf(stderr, "kernel_launch: hipMemsetAsync failed\n"); return; }
    Params p{};
    for (int i = 0; i < 25; ++i) p.in[i] = (const float*)d_in[i];
    p.out = (float*)d_out; p.ws = (unsigned char*)d_ws;
#if ONE_LAUNCH
    p.ph_lo = 0; p.ph_hi = NPH;
    void* args[] = {&p};
    hipError_t e = hipLaunchCooperativeKernel((const void*)mega, dim3(grid), dim3(512), args, LDS_BYTES, stream);
    if (e != hipSuccess) fprintf(stderr, "cooperative launch failed: %s (grid %d)\n", hipGetErrorString(e), grid);
#else
    for (int ph = 0; ph < NPH; ++ph) { p.ph_lo = ph; p.ph_hi = ph + 1; hipLaunchKernelGGL(mega, dim3(grid), dim3(512), LDS_BYTES, stream, p); }
#endif
}
```

```cpp
#include <hip/hip_runtime.h>
#include <hip/hip_cooperative_groups.h>
#include <cstdio>
#include <cstdint>
namespace cg = cooperative_groups;

#ifndef DUP_MASK
#define DUP_MASK 0
#endif
#define DUPN(bit) ((DUP_MASK & (bit)) ? 2 : 1)
#ifndef ONE_LAUNCH
#define ONE_LAUNCH 1
#endif

#define LAS __attribute__((address_space(3)))
typedef unsigned short bf16_t;
typedef short bf16x8 __attribute__((ext_vector_type(8)));
typedef float f32x4 __attribute__((ext_vector_type(4)));
typedef unsigned u32x4 __attribute__((ext_vector_type(4)));
typedef unsigned u32x2 __attribute__((ext_vector_type(2)));

constexpr int D = 1024, TP = 8192, TS = 4096, T = TP + TS, FFN = 2816;
constexpr int NPH = 30;
#ifndef GT_ROWS
#define GT_ROWS 192
#endif
constexpr int GT = GT_ROWS;
constexpr float C2 = 0.125f * 1.4426950408889634f;

constexpr size_t MiB = 1u << 20;
constexpr size_t WS_WF1 = 0, WS_WF2 = 88 * MiB, WS_WEI = 132 * MiB, WS_WEO = 139 * MiB, WS_WOI = 143 * MiB, WS_WOO = 151 * MiB;
constexpr size_t WS_D256 = 155 * MiB, WS_D1024 = 156 * MiB, WS_MOD = 160 * MiB, WS_ROPE = 161 * MiB, WS_X = 162 * MiB, WS_H = 210 * MiB;
constexpr size_t WS_HID = 234 * MiB, WS_Q = 300 * MiB, WS_KP = 312 * MiB, WS_VPT = 314 * MiB, WS_KS = 316 * MiB, WS_VST = 319 * MiB;
constexpr size_t WS_GLU = 322 * MiB, WS_MIX = 346 * MiB, WS_U = 370 * MiB, WS_V = 382 * MiB, WS_FTP = 406 * MiB, WS_FTS = 422 * MiB, WS_BAR = 430 * MiB, WS_RSS = 431 * MiB, WS_GS = 432 * MiB, WS_SW = 433 * MiB, WS_END = 435 * MiB;
constexpr int SW_EI = 8 * 5 * 5632, SW_OI = SW_EI + 2 * 5 * 1792;

constexpr int LDS_BYTES = 131072 + 2048;

struct Params { const float* in[25]; float* out; unsigned char* ws; int ph_lo, ph_hi; };

__device__ __forceinline__ unsigned cvt_pk_bf16(float lo, float hi) { unsigned r; asm volatile("v_cvt_pk_bf16_f32 %0, %1, %2" : "=v"(r) : "v"(lo), "v"(hi)); return r; }
__device__ __forceinline__ bf16_t f2bf(float f) { return (bf16_t)(cvt_pk_bf16(f, 0.f) & 0xffffu); }
__device__ __forceinline__ float bf2f(unsigned h) { return __builtin_bit_cast(float, h << 16); }
typedef _Float16 f16x2 __attribute__((ext_vector_type(2)));
__device__ __forceinline__ unsigned pk_f16(float lo, float hi) { const f16x2 v = {(_Float16)lo, (_Float16)hi}; return __builtin_bit_cast(unsigned, v); }
__device__ __forceinline__ float f16lo(unsigned w) { return (float)__builtin_bit_cast(f16x2, w)[0]; }
__device__ __forceinline__ float f16hi(unsigned w) { return (float)__builtin_bit_cast(f16x2, w)[1]; }
__device__ __forceinline__ void unpack8_f16(u32x4 w, f32x4& a, f32x4& b) { a = (f32x4){f16lo(w.x), f16hi(w.x), f16lo(w.y), f16hi(w.y)}; b = (f32x4){f16lo(w.z), f16hi(w.z), f16lo(w.w), f16hi(w.w)}; }
__device__ __forceinline__ float wave_sum(float v) {
#pragma unroll
    for (int o = 1; o < 64; o <<= 1) v += __shfl_xor(v, o);
    return v;
}
__device__ __forceinline__ float sigmoidf_(float x) { return __builtin_amdgcn_rcpf(1.f + __expf(-x)); }
__device__ __forceinline__ float siluf_(float x) { return x * sigmoidf_(x); }

namespace pg8 {
constexpr int BM = 256, BK = 64, HALF = 128, HTB = HALF * BK * 2, NXCD = 8, WGM = 8;
__device__ __forceinline__ int lds_byte(int r, int c) { const int st = (r >> 4) * 2 + (c >> 5), rr = r & 15, cc = c & 31, ob = rr * 64 + cc * 2; return st * 1024 + (ob ^ (((ob >> 9) & 1) << 5)); }
__device__ __forceinline__ void stage_rc(int b, int& R, int& C) { const int st = b / 1024, sb = b % 1024, swz = sb ^ (((sb >> 9) & 1) << 5); R = (st >> 1) * 16 + swz / 64; C = (st & 1) * 32 + (swz % 64) / 2; }
__device__ __forceinline__ int perm32(int rho) { const int n = rho >> 4, i = rho & 15; return 8 * (i >> 2) + 4 * n + (i & 3); }

struct Unit { int pm, pn; };
struct Gemm { const bf16_t* A; const bf16_t* Bt; int M, N, K; };

struct StaticOrder {
    int nM, nN, nwg, G, c;
    __device__ void init(int M, int N, int G_, int c_, int TM = 256) { nM = M / TM; nN = N / BM; nwg = nM * nN; G = G_; c = c_; }
    __device__ bool next(int i, Unit& u) const {
        const long L = (long)i * G + c; if (L >= nwg) return false;
        int wgid = (int)L; { const int q = nwg / NXCD, r = nwg % NXCD, xcd = wgid % NXCD, off = wgid / NXCD; wgid = (xcd < r ? xcd * (q + 1) : r * (q + 1) + (xcd - r) * q) + off; }
        const int nig = WGM * nN, gid = wgid / nig, fm = gid * WGM, gsz = (nM - fm) < WGM ? (nM - fm) : WGM;
        u.pm = fm + ((wgid % nig) % gsz); u.pn = (wgid % nig) / gsz; return true;
    }
};

template <int TM, class Epi>
__device__ __forceinline__ void gemm_phase(LAS unsigned char* lds, const Gemm g, const StaticOrder& S, const Epi& E) {
    int tid_ = threadIdx.x; asm volatile("" : "+v"(tid_));
    const int tid = tid_, wid = __builtin_amdgcn_readfirstlane(tid >> 6), lane = tid & 63, wr = wid >> 2, wc = wid & 3, fr = lane & 15, fq = lane >> 4;
    const int K = g.K, nt = K / BK;
    constexpr int HA = TM / 2, HTA = HA * BK * 2, MT = TM / 64;
    constexpr int NA = (TM == 128) ? 1 : 2;
    unsigned voffA[2], voffB[2], ldsA[2];
#pragma unroll
    for (int i = 0; i < 2; ++i) { int R, C; stage_rc(tid * 16 + i * 8192, R, C); const int Rb = (R & ~31) + perm32(R & 31);
        voffB[i] = (unsigned)(Rb * K + C) * 2u;
        const bool okA = (tid * 16 + i * 8192) < HTA;
        int Ra, Ca; stage_rc(tid * 16 + (okA ? i * 8192 : 0), Ra, Ca);
        voffA[i] = (unsigned)(Ra * K + Ca) * 2u; ldsA[i] = okA ? (unsigned)i * 8192u : 0u; }
    const size_t kstep = (size_t)(BK * 2);
    const size_t hstep = (size_t)HALF * K * 2;
    const size_t tstep = 2 * hstep;
    const size_t hstepA = (size_t)HA * K * 2, tstepA = 2 * hstepA;
    const unsigned ldsw = (unsigned)wid * 1024u;
    const int aoff = lds_byte(wr * (HA / 2) + fr, fq * 8), boff = lds_byte(wc * 32 + fr, fq * 8);
#define PG8_SA(b, h) (((b) * 2 + (h)) * HTA)
#define PG8_SB(b, h) (4 * HTA + ((b) * 2 + (h)) * HTB)
#define PG8_STAGE(bufoff, gbase, voff) do { _Pragma("unroll") for (int _i = 0; _i < 2; ++_i) \
        __builtin_amdgcn_global_load_lds((const unsigned*)((const char*)(gbase) + (voff)[_i]), (LAS unsigned*)(lds + (bufoff) + ldsw + _i * 8192), 16, 0, 0); } while (0)
#define PG8_STAGEA(bufoff, gbase) do { _Pragma("unroll") for (int _i = 0; _i < NA; ++_i) \
        __builtin_amdgcn_global_load_lds((const unsigned*)((const char*)(gbase) + voffA[_i]), (LAS unsigned*)(lds + (bufoff) + ldsw + ldsA[_i]), 16, 0, 0); } while (0)
#define PG8_LDA(dst, b, h) do { _Pragma("unroll") for (int m = 0; m < MT; ++m) _Pragma("unroll") for (int k = 0; k < 2; ++k) dst[m][k] = *(const LAS bf16x8*)(lds + PG8_SA(b, h) + aoff + m * 2048 + k * 1024); } while (0)
#define PG8_LDB(dst, b, h) do { _Pragma("unroll") for (int n = 0; n < 2; ++n) _Pragma("unroll") for (int k = 0; k < 2; ++k) dst[n][k] = *(const LAS bf16x8*)(lds + PG8_SB(b, h) + boff + n * 2048 + k * 1024); } while (0)
#define PG8_MMA(ai, bj, At, Bt) do { __builtin_amdgcn_s_setprio(1); _Pragma("unroll") for (int m = 0; m < MT; ++m) _Pragma("unroll") for (int n = 0; n < 2; ++n) _Pragma("unroll") for (int k = 0; k < 2; ++k) \
        acc[ai][bj][m][n] = __builtin_amdgcn_mfma_f32_16x16x32_bf16(Bt[n][k], At[m][k], acc[ai][bj][m][n], 0, 0, 0); __builtin_amdgcn_s_setprio(0); } while (0)
#define PG8_WAIT_V(n) asm volatile("s_waitcnt vmcnt(" #n ")" ::: "memory")
#define PG8_WAIT_LOOP do { if constexpr (NA == 2) PG8_WAIT_V(8); else PG8_WAIT_V(6); } while (0)
#define PG8_WAIT_L(n) asm volatile("s_waitcnt lgkmcnt(" #n ")" ::: "memory")
#define PG8_BAR __builtin_amdgcn_s_barrier()
#define PG8_SCHED __builtin_amdgcn_sched_barrier(0)
    Unit cur, nxt; int ui = 0;
    if (!S.next(0, cur)) return;
    f32x4 acc[2][2][MT][2];
#pragma unroll
    for (int a = 0; a < 2; ++a)
#pragma unroll
        for (int b = 0; b < 2; ++b)
#pragma unroll
            for (int m = 0; m < MT; ++m)
#pragma unroll
                for (int n = 0; n < 2; ++n) acc[a][b][m][n] = (f32x4){0.f, 0.f, 0.f, 0.f};
    bf16x8 At[MT][2], B0[2][2], B1[2][2];
    const char* cA = (const char*)g.A + (size_t)cur.pm * tstepA; const char* cB = (const char*)g.Bt + (size_t)cur.pn * tstep;
    PG8_STAGE(PG8_SB(0, 0), cB, voffB); PG8_STAGE(PG8_SB(0, 1), cB + hstep, voffB); PG8_STAGEA(PG8_SA(0, 0), cA); PG8_STAGEA(PG8_SA(0, 1), cA + hstepA);
    if (wr == 1) PG8_BAR;
    if constexpr (NA == 2) PG8_WAIT_V(2); else PG8_WAIT_V(1);
    PG8_BAR;
    PG8_STAGE(PG8_SB(1, 0), cB + kstep, voffB); PG8_STAGEA(PG8_SA(1, 0), cA + kstep); PG8_STAGE(PG8_SB(1, 1), cB + hstep + kstep, voffB);
    if constexpr (NA == 2) PG8_WAIT_V(6); else PG8_WAIT_V(5);
    PG8_BAR;
    for (;;) {
        const bool has_next = S.next(ui + 1, nxt);
        const char* nA = has_next ? (const char*)g.A + (size_t)nxt.pm * tstepA : cA; const char* nB = has_next ? (const char*)g.Bt + (size_t)nxt.pn * tstep : cB;
        for (int t = 0; t < nt; t += 2) {
            const bool last = (t == nt - 2);
            const char* a1 = cA + (size_t)(t + 1) * kstep;
            const char* a2 = last ? nA : cA + (size_t)(t + 2) * kstep; const char* b2 = last ? nB : cB + (size_t)(t + 2) * kstep;
            const char* a3 = a2 + kstep; const char* b3 = b2 + kstep;
            PG8_LDB(B0, 0, 0); PG8_LDB(B1, 0, 1); PG8_SCHED; PG8_LDA(At, 0, 0); PG8_STAGEA(PG8_SA(1, 1), a1 + hstepA);
            PG8_WAIT_LOOP; PG8_WAIT_L(0); PG8_BAR; PG8_MMA(0, 0, At, B0); PG8_MMA(0, 1, At, B1); PG8_BAR; PG8_SCHED;
            PG8_LDA(At, 0, 1); PG8_STAGE(PG8_SB(0, 0), b2, voffB); PG8_STAGE(PG8_SB(0, 1), b2 + hstep, voffB); PG8_STAGEA(PG8_SA(0, 0), a2);
            PG8_WAIT_LOOP; PG8_WAIT_L(0); PG8_BAR; PG8_MMA(1, 0, At, B0); PG8_MMA(1, 1, At, B1); PG8_BAR; PG8_SCHED;
            PG8_LDB(B0, 1, 0); PG8_LDB(B1, 1, 1); PG8_SCHED; PG8_LDA(At, 1, 0); PG8_STAGEA(PG8_SA(0, 1), a2 + hstepA);
            PG8_WAIT_LOOP; PG8_WAIT_L(0); PG8_BAR; PG8_MMA(0, 0, At, B0); PG8_MMA(0, 1, At, B1); PG8_BAR; PG8_SCHED;
            PG8_LDA(At, 1, 1); PG8_STAGE(PG8_SB(1, 0), b3, voffB); PG8_STAGE(PG8_SB(1, 1), b3 + hstep, voffB); PG8_STAGEA(PG8_SA(1, 0), a3);
            PG8_WAIT_LOOP; PG8_WAIT_L(0); PG8_BAR; PG8_MMA(1, 0, At, B0); PG8_MMA(1, 1, At, B1); PG8_BAR; PG8_SCHED;
        }
        if (wr == 0) PG8_BAR;
        E(acc, cur, wr, wc, fr, fq);
        if (!has_next) break;
#pragma unroll
        for (int a = 0; a < 2; ++a)
#pragma unroll
            for (int b = 0; b < 2; ++b)
#pragma unroll
                for (int m = 0; m < MT; ++m)
#pragma unroll
                    for (int n = 0; n < 2; ++n) acc[a][b][m][n] = (f32x4){0.f, 0.f, 0.f, 0.f};
        cur = nxt; cA = nA; cB = nB; ++ui;
        if (wr == 1) PG8_BAR;
    }
    PG8_WAIT_V(0);
    PG8_BAR;
#undef PG8_SA
#undef PG8_SB
#undef PG8_STAGE
#undef PG8_STAGEA
#undef PG8_LDA
#undef PG8_LDB
#undef PG8_MMA
#undef PG8_WAIT_V
#undef PG8_WAIT_L
#undef PG8_WAIT_LOOP
#undef PG8_BAR
#undef PG8_SCHED
}
}
using pg8::Unit;
#define ACCREF(TM) const f32x4 (&acc)[2][2][(TM) / 64][2]

typedef const Params __attribute__((address_space(4)))* KP;
__device__ __forceinline__ KP kparams() { KP kp = (KP)__builtin_amdgcn_kernarg_segment_ptr(); asm volatile("" : "+s"(kp)); return kp; }
#define KIN(i) ((const float*)kparams()->in[i])
#define KWS() ((unsigned char*)kparams()->ws)
#define KOUT() ((float*)kparams()->out)

template <int TM> struct EpiSwiglu {
    static_assert(TM == 256 || TM == 128, "128/256-row tiles never straddle a conditioning group");
    bf16_t* HID; const float* rss; const float* sW; int row_base;
    __device__ __forceinline__ void operator()(ACCREF(TM), const Unit& u, int wr, int wc, int fr, int fq) const {
        const int row0 = row_base + u.pm * TM + wr * (TM / 4) + fr, col0 = u.pn * 128 + wc * 32 + fq * 8;
        const int trow = row_base + u.pm * TM, cond = trow < TP ? 0 : 1 + ((trow - TP) >> 10);
        const float* sw = sW + (size_t)cond * 5632 + u.pn * 256 + wc * 32 + fq * 8;
        const f32x4 sg0 = *(const f32x4*)(sw), sg1 = *(const f32x4*)(sw + 4), su0 = *(const f32x4*)(sw + 128), su1 = *(const f32x4*)(sw + 132);
        float rs[2][TM / 64];
#pragma unroll
        for (int ai = 0; ai < 2; ++ai)
#pragma unroll
            for (int m = 0; m < TM / 64; ++m) rs[ai][m] = rss[row0 + ai * (TM / 2) + m * 16];
#pragma unroll
        for (int ai = 0; ai < 2; ++ai)
#pragma unroll
            for (int m = 0; m < TM / 64; ++m) {
                const float r = rsqrtf(rs[ai][m] * (1.f / 1024.f) + 1e-6f);
                const f32x4 g0 = acc[ai][0][m][0] * r + sg0, g1 = acc[ai][0][m][1] * r + sg1, u0 = acc[ai][1][m][0] * r + su0, u1 = acc[ai][1][m][1] * r + su1;
                u32x4 w;
                w.x = cvt_pk_bf16(siluf_(g0[0]) * u0[0], siluf_(g0[1]) * u0[1]); w.y = cvt_pk_bf16(siluf_(g0[2]) * u0[2], siluf_(g0[3]) * u0[3]);
                w.z = cvt_pk_bf16(siluf_(g1[0]) * u1[0], siluf_(g1[1]) * u1[1]); w.w = cvt_pk_bf16(siluf_(g1[2]) * u1[2], siluf_(g1[3]) * u1[3]);
                *(u32x4*)(HID + (size_t)(row0 + ai * (TM / 2) + m * 16) * FFN + col0) = w;
            }
    }
};

template <int TM> struct EpiResid {
    int layer, sub;
    __device__ __forceinline__ void operator()(ACCREF(TM), const Unit& u, int wr, int wc, int fr, int fq) const {
        constexpr int MT = TM / 64;
        unsigned char* ws = KWS();
        const int sidx = layer * 3 + sub;
        const bool first = (sidx == 0), lastsub = (sidx == 11);
        bf16_t* Xb = (bf16_t*)(ws + WS_X);
        const float* xin_p = KIN(0); const float* xin_s = KIN(1);
        float* xout = KOUT();
        const float* gate = (const float*)(ws + WS_MOD) + (size_t)layer * 5 * 9216 + (3 * sub + 2) * 1024;
        const float coef = (sub == 1) ? 1.f : 0.5f;
        const bool has_next = !lastsub;
        const float* gsn = (const float*)(ws + WS_GS) + (size_t)(sidx + 1) * 5 * 1024; float* rssn = (float*)(ws + WS_RSS) + (size_t)(sidx + 1) * T; bf16_t* XS = (bf16_t*)(ws + WS_H);
        const int row0 = u.pm * TM + wr * (TM / 4) + fr, col0 = u.pn * 256 + wc * 32 + fq * 8;
        const int tr0 = u.pm * TM, c_lo = tr0 < TP ? 0 : 1 + ((tr0 - TP) >> 10), c_hi = (tr0 + TM - 1) < TP ? 0 : 1 + ((tr0 + TM - 1 - TP) >> 10);
        const bool cuni = (c_lo == c_hi);
        f32x4 gvu[2][2], qu[2][2];
#pragma unroll
        for (int bj = 0; bj < 2; ++bj)
#pragma unroll
            for (int n = 0; n < 2; ++n) { gvu[bj][n] = *(const f32x4*)(gate + (size_t)c_lo * 9216 + col0 + bj * 128 + 4 * n); qu[bj][n] = *(const f32x4*)(gsn + (size_t)c_lo * 1024 + col0 + bj * 128 + 4 * n); }
#pragma unroll
        for (int ai = 0; ai < 2; ++ai) {
            f32x4 xv[MT][2][2];
#pragma unroll
            for (int m = 0; m < MT; ++m) {
                const int row = row0 + ai * (TM / 2) + m * 16;
                const int cond = row < TP ? 0 : 1 + ((row - TP) >> 10);
                if (first) {
                    const float* xi = ((row < TP) ? xin_p : (xin_s - (size_t)TP * D)) + (size_t)row * D + col0;
#pragma unroll
                    for (int bj = 0; bj < 2; ++bj)
#pragma unroll
                        for (int n = 0; n < 2; ++n) xv[m][bj][n] = *(const f32x4*)(xi + bj * 128 + 4 * n);
                } else {
#pragma unroll
                    for (int bj = 0; bj < 2; ++bj) {
                        const u32x4 w = *(const u32x4*)(Xb + (size_t)row * D + col0 + bj * 128);
                        xv[m][bj][0] = (f32x4){f16lo(w.x), f16hi(w.x), f16lo(w.y), f16hi(w.y)};
                        xv[m][bj][1] = (f32x4){f16lo(w.z), f16hi(w.z), f16lo(w.w), f16hi(w.w)};
                    }
                }
            }
#pragma unroll
            for (int m = 0; m < MT; ++m) {
                const int row = row0 + ai * (TM / 2) + m * 16;
                const int cond = row < TP ? 0 : 1 + ((row - TP) >> 10);
                const size_t ro = (size_t)row * D + col0;
                f32x4 xn[2][2];
#pragma unroll
                for (int bj = 0; bj < 2; ++bj)
#pragma unroll
                    for (int n = 0; n < 2; ++n) xn[bj][n] = xv[m][bj][n] + (cuni ? gvu[bj][n] : *(const f32x4*)(gate + (size_t)cond * 9216 + col0 + bj * 128 + 4 * n)) * coef * acc[ai][bj][m][n];
                if (has_next) {
                    const float* gq = gsn + (size_t)cond * 1024 + col0;
                    const f32x4 q00 = cuni ? qu[0][0] : *(const f32x4*)(gq), q01 = cuni ? qu[0][1] : *(const f32x4*)(gq + 4), q10 = cuni ? qu[1][0] : *(const f32x4*)(gq + 128), q11 = cuni ? qu[1][1] : *(const f32x4*)(gq + 132);
                    float ss = 0.f;
#pragma unroll
                    for (int bj = 0; bj < 2; ++bj) {
                        const f32x4 a = xn[bj][0], c = xn[bj][1];
                        ss += a[0] * a[0] + a[1] * a[1] + a[2] * a[2] + a[3] * a[3] + c[0] * c[0] + c[1] * c[1] + c[2] * c[2] + c[3] * c[3];
                        const f32x4 sa = a * (bj ? q10 : q00), sc = c * (bj ? q11 : q01);
                        u32x4 w; w.x = cvt_pk_bf16(sa[0], sa[1]); w.y = cvt_pk_bf16(sa[2], sa[3]); w.z = cvt_pk_bf16(sc[0], sc[1]); w.w = cvt_pk_bf16(sc[2], sc[3]);
                        *(u32x4*)(XS + ro + bj * 128) = w;
                    }
                    ss += __shfl_xor(ss, 16); ss += __shfl_xor(ss, 32);
                    if (fq == 0) (void)__hip_atomic_fetch_add(rssn + row, ss, __ATOMIC_RELAXED, __HIP_MEMORY_SCOPE_AGENT);
                }
                if (lastsub) {
#pragma unroll
                    for (int bj = 0; bj < 2; ++bj)
#pragma unroll
                        for (int n = 0; n < 2; ++n) *(f32x4*)(xout + ro + bj * 128 + 4 * n) = xn[bj][n];
                } else {
#pragma unroll
                    for (int bj = 0; bj < 2; ++bj) { const f32x4 a = xn[bj][0], c = xn[bj][1]; u32x4 w; w.x = pk_f16(a[0], a[1]); w.y = pk_f16(a[2], a[3]); w.z = pk_f16(c[0], c[1]); w.w = pk_f16(c[2], c[3]);
                        *(u32x4*)(Xb + ro + bj * 128) = w; }
                }
            }
        }
    }
};

template <int TM> struct EpiEvenIn {
    int j, s;
    __device__ __forceinline__ void operator()(ACCREF(TM), const Unit& u, int wr, int wc, int fr, int fq) const {
        constexpr int MT = TM / 64;
        const int pn = u.pn, rowb = u.pm * TM + wr * (TM / 4) + fr;
        unsigned char* ws = KWS();
        const float* rss = (const float*)(ws + WS_RSS) + (size_t)s * T;
        const float* sWb = (const float*)(ws + WS_SW) + SW_EI + (size_t)j * 5 * 1792 + pn * 256 + wc * 32 + fq * 8;
        const int tr0 = u.pm * TM, c_lo = tr0 < TP ? 0 : 1 + ((tr0 - TP) >> 10), c_hi = (tr0 + TM - 1) < TP ? 0 : 1 + ((tr0 + TM - 1 - TP) >> 10);
        const bool cuni = (c_lo == c_hi);
        f32x4 su[2][2];
#pragma unroll
        for (int bj = 0; bj < 2; ++bj)
#pragma unroll
            for (int n = 0; n < 2; ++n) su[bj][n] = *(const f32x4*)(sWb + (size_t)c_lo * 1792 + 128 * bj + 4 * n);
        float rsv[2][MT];
#pragma unroll
        for (int ai = 0; ai < 2; ++ai)
#pragma unroll
            for (int m = 0; m < MT; ++m) rsv[ai][m] = rsqrtf(rss[rowb + ai * (TM / 2) + m * 16] * (1.f / 1024.f) + 1e-6f);
        if (pn >= 3) {
            bf16_t* glu = (bf16_t*)(ws + WS_GLU);
#pragma unroll
            for (int ai = 0; ai < 2; ++ai)
#pragma unroll
                for (int m = 0; m < MT; ++m) {
                    const int row = rowb + ai * (TM / 2) + m * 16;
                    const float rs = rsv[ai][m];
                    const float* sw = sWb + (size_t)(row < TP ? 0 : 1 + ((row - TP) >> 10)) * 1792;
                    bf16_t* o = glu + (size_t)row * 512 + (pn - 3) * 128 + wc * 32 + fq * 8;
                    u32x4 ow;
#pragma unroll
                    for (int n = 0; n < 2; ++n) {
                        const f32x4 a = acc[ai][0][m][n] * rs + (cuni ? su[0][n] : *(const f32x4*)(sw + 4 * n)), b = acc[ai][1][m][n] * rs + (cuni ? su[1][n] : *(const f32x4*)(sw + 128 + 4 * n));
                        f32x4 r; r[0] = a[0] * sigmoidf_(b[0]); r[1] = a[1] * sigmoidf_(b[1]); r[2] = a[2] * sigmoidf_(b[2]); r[3] = a[3] * sigmoidf_(b[3]);
                        if (n == 0) { ow.x = pk_f16(r[0], r[1]); ow.y = pk_f16(r[2], r[3]); } else { ow.z = pk_f16(r[0], r[1]); ow.w = pk_f16(r[2], r[3]); }
                    }
                    *(u32x4*)o = ow;
                }
            return;
        }
        const bool isq = pn < 2, isv = (!isq) && (wc >= 2);
        const int head = isq ? pn * 4 + wc : (wc & 1);
        const float* gam = (isq ? KIN(13) : KIN(14)) + j * 64 + 8 * fq;
        f32x4 gmv[2][2];
#pragma unroll
        for (int bj = 0; bj < 2; ++bj)
#pragma unroll
            for (int n = 0; n < 2; ++n) gmv[bj][n] = *(const f32x4*)(gam + 32 * bj + 4 * n);
        const float* ropec = (const float*)(ws + WS_ROPE) + 4 * fq;
        float* ncb = KOUT() + (size_t)T * D + (isv ? (size_t)32 * 2 * 256 * 128 : 0) + (size_t)j * 256 * 128 + head * 64 + 8 * fq;
#pragma unroll 1
        for (int am = 0; am < 2 * MT; ++am) {
            const int ai = am / MT, m = am % MT;
            const int row = rowb + ai * (TM / 2) + m * 16;
            const bool samp = row >= TP;
            f32x4 v[2][2];
#pragma unroll
            for (int a2 = 0; a2 < 2; ++a2)
#pragma unroll
                for (int m2 = 0; m2 < MT; ++m2)
                    if (a2 == ai && m2 == m) {
#pragma unroll
                        for (int bj = 0; bj < 2; ++bj)
#pragma unroll
                            for (int n = 0; n < 2; ++n) v[bj][n] = acc[a2][bj][m2][n];
                    }
            {
                float rs0 = 0.f;
#pragma unroll
                for (int a2 = 0; a2 < 2; ++a2)
#pragma unroll
                    for (int m2 = 0; m2 < MT; ++m2) rs0 = (a2 == ai && m2 == m) ? rsv[a2][m2] : rs0;
                const float* sw = sWb + (size_t)(row < TP ? 0 : 1 + ((row - TP) >> 10)) * 1792;
#pragma unroll
                for (int bj = 0; bj < 2; ++bj)
#pragma unroll
                    for (int n = 0; n < 2; ++n) v[bj][n] = v[bj][n] * rs0 + (cuni ? su[bj][n] : *(const f32x4*)(sw + 128 * bj + 4 * n));
            }
            if (!isv) {
                float ss = 0.f;
#pragma unroll
                for (int bj = 0; bj < 2; ++bj)
#pragma unroll
                    for (int n = 0; n < 2; ++n) ss += v[bj][n][0] * v[bj][n][0] + v[bj][n][1] * v[bj][n][1] + v[bj][n][2] * v[bj][n][2] + v[bj][n][3] * v[bj][n][3];
                ss += __shfl_xor(ss, 16); ss += __shfl_xor(ss, 32);
                const float rs = rsqrtf(ss * (1.f / 64.f) + 1e-6f);
#pragma unroll
                for (int bj = 0; bj < 2; ++bj)
#pragma unroll
                    for (int n = 0; n < 2; ++n) v[bj][n] = v[bj][n] * gmv[bj][n] * rs;
            }
            int b, l;
            if (samp) { const int tl = row - TP; b = tl >> 10; l = tl & 1023; } else { b = row >> 8; l = row & 255; }
            if (samp && !isv) {
#pragma unroll
                for (int bj = 0; bj < 2; ++bj) {
                    const f32x4 c4 = *(const f32x4*)(ropec + l * 32 + 16 * bj), s4 = *(const f32x4*)(ropec + 32768 + l * 32 + 16 * bj);
                    f32x4 a = v[bj][0], r;
                    r[0] = a[0] * c4[0] - a[1] * s4[0]; r[1] = a[0] * s4[0] + a[1] * c4[0]; r[2] = a[2] * c4[1] - a[3] * s4[1]; r[3] = a[2] * s4[1] + a[3] * c4[1];
                    v[bj][0] = r; a = v[bj][1];
                    r[0] = a[0] * c4[2] - a[1] * s4[2]; r[1] = a[0] * s4[2] + a[1] * c4[2]; r[2] = a[2] * c4[3] - a[3] * s4[3]; r[3] = a[2] * s4[3] + a[3] * c4[3];
                    v[bj][1] = r;
                }
            }
            if (!samp && !isq) {
                float* nc = ncb + ((size_t)(b * 2) * 256 + l) * 128;
#pragma unroll
                for (int bj = 0; bj < 2; ++bj) { *(f32x4*)(nc + 32 * bj) = v[bj][0]; *(f32x4*)(nc + 32 * bj + 4) = v[bj][1]; }
            }
            if (!isv) {
                const float sc = isq ? C2 : 1.f;
                bf16_t* dst;
                if (isq) dst = (bf16_t*)(ws + WS_Q) + (size_t)row * 512 + head * 64;
                else if (samp) dst = (bf16_t*)(ws + WS_KS) + (size_t)j * 4 * 2 * 1536 * 64 + ((size_t)(b * 2 + head) * 1536 + 512 + l) * 64;
                else dst = (bf16_t*)(ws + WS_KP) + ((size_t)(b * 2 + head) * 256 + l) * 64;
#pragma unroll
                for (int bj = 0; bj < 2; ++bj) { const f32x4 a = v[bj][0] * sc, c = v[bj][1] * sc; u32x4 w; w.x = cvt_pk_bf16(a[0], a[1]); w.y = cvt_pk_bf16(a[2], a[3]); w.z = cvt_pk_bf16(c[0], c[1]); w.w = cvt_pk_bf16(c[2], c[3]);
                    *(u32x4*)(dst + 32 * bj + 8 * fq) = w; }
            } else {
                bf16_t* vt; size_t vp;
                if (samp) { vt = (bf16_t*)(ws + WS_VST) + (size_t)j * 4 * 2 * 64 * 1536 + (size_t)(b * 2 + head) * 64 * 1536 + 512 + l; vp = 1536; }
                else { vt = (bf16_t*)(ws + WS_VPT) + (size_t)(b * 2 + head) * 64 * 256 + l; vp = 256; }
#pragma unroll
                for (int bj = 0; bj < 2; ++bj)
#pragma unroll
                    for (int n = 0; n < 2; ++n)
#pragma unroll
                        for (int jj = 0; jj < 4; ++jj) vt[(size_t)(32 * bj + 8 * fq + 4 * n + jj) * vp] = f2bf(v[bj][n][jj]);
            }
        }
    }
};

template <int TM> struct EpiOddIn {
    bf16_t* FTp; bf16_t* FTs; bf16_t* U; float* V; const float* rss; const float* sW;
    __device__ __forceinline__ void operator()(ACCREF(TM), const Unit& u, int wr, int wc, int fr, int fq) const {
        const int pn = u.pn, rowb = u.pm * TM + wr * (TM / 4) + fr;
        constexpr int MT = TM / 64;
        const int tr0 = u.pm * TM, c_lo = tr0 < TP ? 0 : 1 + ((tr0 - TP) >> 10), c_hi = (tr0 + TM - 1) < TP ? 0 : 1 + ((tr0 + TM - 1 - TP) >> 10);
        const float* swb = sW + pn * 256 + wc * 32 + fq * 8;
        f32x4 su[2][2];
#pragma unroll
        for (int bj = 0; bj < 2; ++bj)
#pragma unroll
            for (int n = 0; n < 2; ++n) su[bj][n] = *(const f32x4*)(swb + (size_t)c_lo * 2048 + 128 * bj + 4 * n);
        float rsv[2][MT];
#pragma unroll
        for (int ai = 0; ai < 2; ++ai)
#pragma unroll
            for (int m = 0; m < MT; ++m) rsv[ai][m] = rss[rowb + ai * (TM / 2) + m * 16];
#pragma unroll
        for (int ai = 0; ai < 2; ++ai)
#pragma unroll
            for (int m = 0; m < MT; ++m) {
                const int row = rowb + ai * (TM / 2) + m * 16;
                const float rs = rsqrtf(rsv[ai][m] * (1.f / 1024.f) + 1e-6f);
                f32x4 vv[2][2];
                if (c_lo == c_hi) {
#pragma unroll
                    for (int bj = 0; bj < 2; ++bj)
#pragma unroll
                        for (int n = 0; n < 2; ++n) vv[bj][n] = acc[ai][bj][m][n] * rs + su[bj][n];
                } else {
                    const float* sw = swb + (size_t)(row < TP ? 0 : 1 + ((row - TP) >> 10)) * 2048;
#pragma unroll
                    for (int bj = 0; bj < 2; ++bj)
#pragma unroll
                        for (int n = 0; n < 2; ++n) vv[bj][n] = acc[ai][bj][m][n] * rs + *(const f32x4*)(sw + 128 * bj + 4 * n);
                }
                if (pn < 4) {
                    const int isS = pn >> 1;
                    bf16_t* dst; size_t pitch;
                    if (row < TP) { const int b = row >> 8, l = row & 255; dst = FTp + (size_t)b * 512 * 512 + isS * 256 + l; pitch = 512; }
                    else { const int tl = row - TP, b = tl >> 10, l = tl & 1023; dst = FTs + (size_t)b * 512 * 2048 + isS * 1024 + l; pitch = 2048; }
#pragma unroll
                    for (int bj = 0; bj < 2; ++bj)
#pragma unroll
                        for (int n = 0; n < 2; ++n)
#pragma unroll
                            for (int j = 0; j < 4; ++j) { const int nf = (pn & 1) * 256 + 128 * bj + 32 * wc + 8 * fq + 4 * n + j; dst[(size_t)nf * pitch] = f2bf(vv[bj][n][j]); }
                } else if (pn < 6) {
#pragma unroll
                    for (int bj = 0; bj < 2; ++bj) { const f32x4 a = vv[bj][0], c = vv[bj][1]; u32x4 w; w.x = cvt_pk_bf16(a[0], a[1]); w.y = cvt_pk_bf16(a[2], a[3]); w.z = cvt_pk_bf16(c[0], c[1]); w.w = cvt_pk_bf16(c[2], c[3]);
                        *(u32x4*)(U + (size_t)row * 512 + (pn - 4) * 256 + 128 * bj + 32 * wc + 8 * fq) = w; }
                } else {
#pragma unroll
                    for (int bj = 0; bj < 2; ++bj)
                    { u32x4 ow; ow.x = pk_f16(vv[bj][0][0], vv[bj][0][1]); ow.y = pk_f16(vv[bj][0][2], vv[bj][0][3]); ow.z = pk_f16(vv[bj][1][0], vv[bj][1][1]); ow.w = pk_f16(vv[bj][1][2], vv[bj][1][3]);
                        *(u32x4*)((bf16_t*)V + (size_t)row * 512 + (pn - 6) * 256 + 128 * bj + 32 * wc + 8 * fq) = ow; }
                }
            }
    }
};

struct EpiFourier {
    bf16_t* MIX; int tok0, L;
    __device__ __forceinline__ void operator()(ACCREF(256), const Unit& u, int wr, int wc, int fr, int fq) const {
        const int b = u.pn >> 1, nb = (u.pn & 1) * 256 + 32 * wc + 8 * fq;
#pragma unroll
        for (int ai = 0; ai < 2; ++ai)
#pragma unroll
            for (int m = 0; m < 4; ++m) {
                const int lp = u.pm * 256 + wr * 64 + fr + ai * 128 + m * 16;
#pragma unroll
                for (int bj = 0; bj < 2; ++bj) { const f32x4 a = acc[ai][bj][m][0], c = acc[ai][bj][m][1]; u32x4 w; w.x = cvt_pk_bf16(a[0], a[1]); w.y = cvt_pk_bf16(a[2], a[3]); w.z = cvt_pk_bf16(c[0], c[1]); w.w = cvt_pk_bf16(c[2], c[3]);
                    *(u32x4*)(MIX + (size_t)(tok0 + b * L + lp) * D + nb + 128 * bj) = w; }
            }
    }
};

#define XB_TMO      128
#define XB_XCNT(j)  (256  + 64 * (j))
#define XB_XSUB(j)  (1280 + 64 * (j))
#define XB_XGEN(j)  (2304 + 64 * (j))
#define XB_TOP      3328
#define XB_TOPGEN   3392
#define XCD_BAR_WORDS 3456
#define XB_SPIN_CAP (1u << 20)
__device__ __forceinline__ unsigned xb_ld(unsigned* p)              { return __hip_atomic_load(p, __ATOMIC_RELAXED, __HIP_MEMORY_SCOPE_AGENT); }
__device__ __forceinline__ unsigned xb_add(unsigned* p, unsigned v) { return __hip_atomic_fetch_add(p, v, __ATOMIC_RELAXED, __HIP_MEMORY_SCOPE_AGENT); }
__device__ __forceinline__ unsigned xb_xcc_id() { return (unsigned)__builtin_amdgcn_s_getreg((3 << 11) | 20) & 0xFu; }
#define XB_SPIN(cond, bar) do { unsigned _sp = 0; while (cond) { __builtin_amdgcn_s_sleep(1); \
    if ((++_sp & 255u) == 0u) { if (xb_ld(&(bar)[XB_TMO])) break; if (_sp > XB_SPIN_CAP) { atomicAdd(&(bar)[XB_TMO], 1u); break; } } } } while (0)
__device__ __forceinline__ void xcd_barrier_complete(unsigned* bar, unsigned x, unsigned& nloc, unsigned& nx) {
    const unsigned G = gridDim.x;
    unsigned sum, cnt, mine, sp = 0u;
    for (;;) {
        sum = 0u; cnt = 0u; mine = 0u;
#pragma unroll
        for (unsigned j = 0; j < 16; ++j) { const unsigned c = xb_ld(&bar[XB_XCNT(j)]); sum += c; cnt += (c > 0u) ? 1u : 0u; mine = (j == x) ? c : mine; }
        if (sum == G) break;
        __builtin_amdgcn_s_sleep(1);
        if ((++sp & 255u) == 0u) { if (xb_ld(&bar[XB_TMO])) break; if (sp > XB_SPIN_CAP) { atomicAdd(&bar[XB_TMO], 1u); break; } }
    }
    nloc = mine > 0u ? mine : 1u; nx = cnt > 0u ? cnt : 1u;
}
__device__ __noinline__ void xcd_barrier(unsigned* bar, volatile LAS unsigned* st) {
    asm volatile("s_waitcnt vmcnt(0)" ::: "memory");
    __syncthreads();
    if (threadIdx.x == 0) {
        const unsigned x = xb_xcc_id();
        __builtin_amdgcn_s_waitcnt(0);
        unsigned nloc = st[0], nx = st[1];
        if (nloc == 0u) { xcd_barrier_complete(bar, x, nloc, nx); st[0] = nloc; st[1] = nx; }
        const unsigned old = xb_add(&bar[XB_XSUB(x)], 1u);
        const unsigned gen = old / nloc;
        if (old + 1u == (gen + 1u) * nloc) {
            __builtin_amdgcn_fence(__ATOMIC_RELEASE, "agent");
            asm volatile("s_waitcnt vmcnt(0)" ::: "memory");
            const unsigned og = xb_add(&bar[XB_TOP], 1u);
            const unsigned tg = og / nx;
            if (og + 1u == (tg + 1u) * nx) xb_add(&bar[XB_TOPGEN], 1u);
            else XB_SPIN(xb_ld(&bar[XB_TOPGEN]) == tg, bar);
            __builtin_amdgcn_fence(__ATOMIC_ACQUIRE, "agent");
            xb_add(&bar[XB_XGEN(x)], 1u);
            asm volatile("s_waitcnt vmcnt(0)" ::: "memory");
        } else {
            __builtin_amdgcn_fence(__ATOMIC_ACQUIRE, "agent");
            XB_SPIN(xb_ld(&bar[XB_XGEN(x)]) == gen, bar);
            asm volatile("s_waitcnt vmcnt(0)" ::: "memory");
        }
    }
    __syncthreads();
}

struct TrItem { const float* src; bf16_t* dst; int Nsrc, K; };
__device__ __forceinline__ TrItem tr_decode(const Params* kp, int it) {
    constexpr int I_F1 = 8 * 16 * 176, I_F2 = 8 * 44 * 32, I_EI = 2 * 16 * 56, I_EO = 2 * 16 * 32, I_OI = 2 * 16 * 32;
    unsigned char* ws = kp->ws;
    TrItem t; int r = it;
    if (r < I_F1) { const int mat = r / (16 * 176), rr = r % (16 * 176), kb = rr / 176, n0 = (rr % 176) * 32;
        const int pn = n0 >> 8, bj = (n0 >> 7) & 1, q = n0 & 127, src = bj * FFN + pn * 128 + q;
        t.Nsrc = 5632; t.K = D; t.src = kp->in[9] + (size_t)mat * D * 5632 + (size_t)(kb * 64) * 5632 + src; t.dst = (bf16_t*)(ws + WS_WF1) + ((size_t)mat * 5632 + n0) * D + kb * 64; return t; }
    r -= I_F1;
    if (r < I_F2) { const int mat = r / (44 * 32), rr = r % (44 * 32), kb = rr / 32, n0 = (rr % 32) * 32;
        t.Nsrc = D; t.K = FFN; t.src = kp->in[10] + (size_t)mat * FFN * D + (size_t)(kb * 64) * D + n0; t.dst = (bf16_t*)(ws + WS_WF2) + ((size_t)mat * D + n0) * FFN + kb * 64; return t; }
    r -= I_F2;
    if (r < I_EI) { const int mat = r / (16 * 56), rr = r % (16 * 56), kb = rr / 56, n0 = (rr % 56) * 32;
        const int pn = n0 >> 8, bj = (n0 >> 7) & 1, wc = (n0 >> 5) & 3; int src;
        if (pn < 2) src = (pn * 4 + wc) * 64 + 32 * bj;
        else if (pn == 2) src = (wc < 2 ? 512 + wc * 64 : 640 + (wc - 2) * 64) + 32 * bj;
        else src = 768 + bj * 512 + (pn - 3) * 128 + 32 * wc;
        t.Nsrc = 1792; t.K = D; t.src = kp->in[11] + (size_t)mat * D * 1792 + (size_t)(kb * 64) * 1792 + src; t.dst = (bf16_t*)(ws + WS_WEI) + ((size_t)mat * 1792 + n0) * D + kb * 64; return t; }
    r -= I_EI;
    if (r < I_EO) { const int mat = r / (16 * 32), rr = r % (16 * 32), kb = rr / 32, n0 = (rr % 32) * 32;
        t.Nsrc = D; t.K = D; t.src = kp->in[12] + (size_t)mat * D * D + (size_t)(kb * 64) * D + n0; t.dst = (bf16_t*)(ws + WS_WEO) + ((size_t)mat * D + n0) * D + kb * 64; return t; }
    r -= I_EO;
    if (r < I_OI) { const int mat = r / (16 * 32), rr = r % (16 * 32), kb = rr / 32, n0 = (rr % 32) * 32;
        t.Nsrc = 1536; t.K = D; t.src = kp->in[19] + (size_t)mat * D * 1536 + (size_t)(kb * 64) * 1536 + 512 + n0; t.dst = (bf16_t*)(ws + WS_WOI) + ((size_t)mat * 2048 + 1024 + n0) * D + kb * 64; return t; }
    r -= I_OI;
    { const int mat = r / (16 * 32), rr = r % (16 * 32), kb = rr / 32, n0 = (rr % 32) * 32;
        t.Nsrc = D; t.K = D; t.src = kp->in[20] + (size_t)mat * D * D + (size_t)(kb * 64) * D + n0; t.dst = (bf16_t*)(ws + WS_WOO) + ((size_t)mat * D + n0) * D + kb * 64; return t; }
}
__device__ __noinline__ void pro_a(const Params* kp, unsigned char* lds, int G) {
    const int tid = threadIdx.x, lane = tid & 63, wave = tid >> 6;
    float* scr = (float*)(lds + wave * 8704);
    const int gw = blockIdx.x * 8 + wave, NGW = G * 8;
    constexpr int TOT = 8 * 16 * 176 + 8 * 44 * 32 + 2 * 16 * 56 + 3 * 2 * 16 * 32;
    if (gw >= TOT) return;
    const int lr = lane >> 5, lc = lane & 31;
    TrItem cur = tr_decode(kp, gw);
    float r[32];
#pragma unroll
    for (int i = 0; i < 32; ++i) r[i] = cur.src[(size_t)(2 * i + lr) * cur.Nsrc + lc];
    for (int it = gw; it < TOT; it += NGW) {
        const bool has_next = it + NGW < TOT;
        TrItem nxt = cur; if (has_next) nxt = tr_decode(kp, it + NGW);
#pragma unroll
        for (int i = 0; i < 32; ++i) scr[(2 * i + lr) * 33 + lc] = r[i];
        __builtin_amdgcn_fence(__ATOMIC_RELEASE, "wavefront"); __builtin_amdgcn_wave_barrier();
        if (has_next) {
#pragma unroll
            for (int i = 0; i < 32; ++i) r[i] = nxt.src[(size_t)(2 * i + lr) * nxt.Nsrc + lc];
        }
        const int c = lane & 7;
#pragma unroll
        for (int j = 0; j < 4; ++j) { const int n = (lane >> 3) + 8 * j; const float* sp = scr + (8 * c) * 33 + n;
            u32x4 o; o.x = cvt_pk_bf16(sp[0 * 33], sp[1 * 33]); o.y = cvt_pk_bf16(sp[2 * 33], sp[3 * 33]); o.z = cvt_pk_bf16(sp[4 * 33], sp[5 * 33]); o.w = cvt_pk_bf16(sp[6 * 33], sp[7 * 33]);
            *(u32x4*)(cur.dst + (size_t)n * cur.K + 8 * c) = o; }
        __builtin_amdgcn_fence(__ATOMIC_RELEASE, "wavefront"); __builtin_amdgcn_wave_barrier();
        cur = nxt;
    }
}
__device__ __noinline__ void pro_b(const Params* kp, unsigned char* lds, int G) {
    const int tid = threadIdx.x, lane = tid & 63, wave = tid >> 6;
    unsigned char* ws = kp->ws;
    {
        float* Wt = (float*)lds;
        float* cs = Wt + 32 * 132; float* sn = cs + 128;
        if (tid < 128) { float sv, cv; sincospif((float)tid * (1.f / 64.f), &sv, &cv); cs[tid] = cv * 0.08838834764831845f; sn[tid] = sv * 0.08838834764831845f; }
        for (int item = blockIdx.x; item < 256; item += G) {
            const int j = item >> 7, g = (item >> 5) & 3, k0 = (item & 31) * 32;
            const float* W = kp->in[19] + (size_t)j * D * 1536;
            for (int e = tid; e < 32 * 128; e += 512) { const int kk = e >> 7, c = e & 127; Wt[kk * 132 + c] = W[(size_t)(k0 + kk) * 1536 + g * 128 + c]; }
            __syncthreads();
            const int cp = tid & 127, kg = tid >> 7;
            float aC[8], aS[8];
#pragma unroll
            for (int i = 0; i < 8; ++i) { aC[i] = 0.f; aS[i] = 0.f; }
            for (int c = 0; c < 128; c += 4) {
                float cv[4], sv[4];
#pragma unroll
                for (int q = 0; q < 4; ++q) { const int idx = ((c + q) * cp) & 127; cv[q] = cs[idx]; sv[q] = sn[idx]; }
#pragma unroll
                for (int i = 0; i < 8; ++i) { const f32x4 w = *(const f32x4*)(Wt + (kg * 8 + i) * 132 + c);
                    aC[i] += w[0] * cv[0] + w[1] * cv[1] + w[2] * cv[2] + w[3] * cv[3]; aS[i] += w[0] * sv[0] + w[1] * sv[1] + w[2] * sv[2] + w[3] * sv[3]; }
            }
            bf16_t* oc = (bf16_t*)(ws + WS_WOI) + ((size_t)j * 2048 + g * 128 + cp) * D + k0 + kg * 8;
            bf16_t* os = oc + (size_t)512 * D;
            u32x4 w;
            w.x = cvt_pk_bf16(aC[0], aC[1]); w.y = cvt_pk_bf16(aC[2], aC[3]); w.z = cvt_pk_bf16(aC[4], aC[5]); w.w = cvt_pk_bf16(aC[6], aC[7]); *(u32x4*)oc = w;
            w.x = cvt_pk_bf16(aS[0], aS[1]); w.y = cvt_pk_bf16(aS[2], aS[3]); w.z = cvt_pk_bf16(aS[4], aS[5]); w.w = cvt_pk_bf16(aS[6], aS[7]); *(u32x4*)os = w;
            __syncthreads();
        }
    }
    (void)lane; (void)wave; (void)ws;
}
__device__ __noinline__ void pro_c(const Params* kp, unsigned char* lds, int G) {
    const int tid = threadIdx.x, lane = tid & 63, wave = tid >> 6;
    unsigned char* ws = kp->ws;
    {
        const int gt = blockIdx.x * 512 + tid, NGT = G * 512;
        for (int it = gt; it < (256 * 512 + 1024 * 2048) / 8; it += NGT) {
            int e = it * 8; int L; bf16_t* dst;
            if (e < 256 * 512) { L = 256; dst = (bf16_t*)(ws + WS_D256); } else { e -= 256 * 512; L = 1024; dst = (bf16_t*)(ws + WS_D1024); }
            const int lp = e / (2 * L), cc = e % (2 * L), isS = cc >= L, l0 = cc - (isS ? L : 0);
            const float nrm = (L == 256) ? 0.0625f : 0.03125f;
            float v[8];
#pragma unroll
            for (int i = 0; i < 8; ++i) { const int mm = ((l0 + i) * lp) & (L - 1); float s, c; sincospif(2.f * (float)mm / (float)L, &s, &c); v[i] = isS ? -s * nrm : c * nrm; }
            u32x4 w; w.x = cvt_pk_bf16(v[0], v[1]); w.y = cvt_pk_bf16(v[2], v[3]); w.z = cvt_pk_bf16(v[4], v[5]); w.w = cvt_pk_bf16(v[6], v[7]);
            *(u32x4*)(dst + e) = w;
        }
        for (int it = gt; it < 12 * T; it += NGT) ((float*)(ws + WS_RSS))[it] = 0.f;
        for (int it = gt; it < 1024 * 32; it += NGT) {
            const int l = it >> 5, i = it & 31, f = i & 15;
            const float pos = (float)((i < 16) ? (l >> 6) : (l & 63));
            const float invf = 1.0f / powf(10000.f, (float)(2 * f) / 32.f);
            const float ang = pos * invf;
            ((float*)(ws + WS_ROPE))[it] = cosf(ang); ((float*)(ws + WS_ROPE))[32768 + it] = sinf(ang);
        }
        for (int it = gt; it < 4 * 2 * 512 * 128; it += NGT) {
            const int d = it & 63, kvh = (it >> 6) & 1, s = (it >> 7) & 511, j = (it >> 16) & 1, b = it >> 17;
            ((bf16_t*)(ws + WS_KS))[((size_t)((j * 4 + b) * 2 + kvh) * 1536 + s) * 64 + d] = f2bf(kp->in[2][it]);
            ((bf16_t*)(ws + WS_VST))[((size_t)((j * 4 + b) * 2 + kvh) * 64 + d) * 1536 + s] = f2bf(kp->in[3][it]);
        }
    }
    (void)lane; (void)wave; (void)ws;
}
__device__ __noinline__ void pro_d(const Params* kp, unsigned char* lds, int G) {
    const int tid = threadIdx.x;
    unsigned char* ws = kp->ws;
    float* sl = (float*)lds;
    float* red = sl + 5 * 1024;
    for (int e = tid; e < 5 * 1024; e += 512) { const int c = e >> 10, k = e & 1023; const float x = (c == 0) ? kp->in[5][k] : kp->in[4][(c - 1) * 1024 + k]; sl[e] = siluf_(x); }
    __syncthreads();
    for (int item = blockIdx.x; item < 4 * 144; item += G) {
        const int layer = item / 144, c0 = (item % 144) * 64;
        const int cl = tid & 63, kq = tid >> 6;
        const float* W = kp->in[6] + (size_t)layer * D * 9216 + (size_t)(kq * 128) * 9216 + c0 + cl;
        const float* s0 = sl + kq * 128;
        float a0 = 0.f, a1 = 0.f, a2 = 0.f, a3 = 0.f, a4 = 0.f;
#pragma unroll 1
        for (int kb = 0; kb < 128; kb += 32) {
            float w[32];
#pragma unroll
            for (int i = 0; i < 32; ++i) w[i] = W[(size_t)(kb + i) * 9216];
#pragma unroll
            for (int i = 0; i < 32; ++i) { const int k = kb + i; a0 += s0[k] * w[i]; a1 += s0[1024 + k] * w[i]; a2 += s0[2048 + k] * w[i]; a3 += s0[3072 + k] * w[i]; a4 += s0[4096 + k] * w[i]; }
        }
        red[(kq * 5 + 0) * 64 + cl] = a0; red[(kq * 5 + 1) * 64 + cl] = a1; red[(kq * 5 + 2) * 64 + cl] = a2; red[(kq * 5 + 3) * 64 + cl] = a3; red[(kq * 5 + 4) * 64 + cl] = a4;
        __syncthreads();
        if (tid < 5 * 64) { const int c = tid >> 6, cc = tid & 63;
            float v = kp->in[7][layer * 9216 + c0 + cc];
#pragma unroll
            for (int q = 0; q < 8; ++q) v += red[(q * 5 + c) * 64 + cc];
            ((float*)(ws + WS_MOD))[((size_t)layer * 5 + c) * 9216 + c0 + cc] = v; }
        __syncthreads();
    }
}
__device__ __forceinline__ void prologue(const Params* kp, unsigned char* lds, int G) {
    if (blockIdx.x & 1) { pro_b(kp, lds, G); __syncthreads(); pro_c(kp, lds, G); __syncthreads(); pro_d(kp, lds, G); __syncthreads(); pro_a(kp, lds, G); }
    else { pro_a(kp, lds, G); __syncthreads(); pro_b(kp, lds, G); __syncthreads(); pro_c(kp, lds, G); __syncthreads(); pro_d(kp, lds, G); }
}

__device__ __noinline__ void pre_phase(const Params* kp, int G) {
    const int tid = threadIdx.x, lane = tid & 63, gw = blockIdx.x * 8 + (tid >> 6), NGW = G * 8;
    unsigned char* ws = kp->ws;
    const float* MOD = (const float*)(ws + WS_MOD);
    for (int t = gw; t < T; t += NGW) {
        const float* xr = (t < TP) ? kp->in[0] + (size_t)t * D : kp->in[1] + (size_t)(t - TP) * D;
        const int cond = (t < TP) ? 0 : 1 + ((t - TP) >> 10);
        const float* sc = MOD + (size_t)cond * 9216 + 1024;
        f32x4 v[4]; float ss = 0.f;
#pragma unroll
        for (int j = 0; j < 4; ++j) { v[j] = *(const f32x4*)(xr + lane * 4 + 256 * j); ss += v[j][0] * v[j][0] + v[j][1] * v[j][1] + v[j][2] * v[j][2] + v[j][3] * v[j][3]; }
        ss = wave_sum(ss);
        if (lane == 0) ((float*)(ws + WS_RSS))[t] = ss;
#pragma unroll
        for (int j = 0; j < 4; ++j) {
            const int c = lane * 4 + 256 * j;
            const f32x4 o = v[j] * *(const f32x4*)(kp->in[8] + c) * (*(const f32x4*)(sc + c) + 1.f);
            u32x2 w; w.x = cvt_pk_bf16(o[0], o[1]); w.y = cvt_pk_bf16(o[2], o[3]);
            *(u32x2*)((bf16_t*)(ws + WS_H) + (size_t)t * D + c) = w;
        }
    }
    for (int e = blockIdx.x * 512 + tid; e < 12 * 5 * 1024; e += G * 512) {
        const int k = e & 1023, c = (e >> 10) % 5, sidx = e / 5120, layer = sidx / 3, sub = sidx % 3;
        ((float*)(ws + WS_GS))[e] = kp->in[8][sidx * 1024 + k] * (1.f + MOD[((size_t)layer * 5 + c) * 9216 + (3 * sub + 1) * 1024 + k]);
    }
}

__device__ __noinline__ void shiftw_phase(const Params* kp, int G) {
    const int tid = threadIdx.x, lane = tid & 63, fr = lane & 15, fq = lane >> 4, gw = blockIdx.x * 8 + (tid >> 6), NGW = G * 8;
    unsigned char* ws = kp->ws;
    const float* MOD = (const float*)(ws + WS_MOD);
    constexpr int C_F1 = 8 * 352, C_EI = 2 * 112, C_OI = 2 * 128;
    for (int ck = gw; ck < C_F1 + C_EI + C_OI; ck += NGW) {
        const bf16_t* wrow; const float* shift; float* dst; int N;
        if (ck < C_F1) { const int mat = ck / 352, n0 = (ck % 352) * 16, layer = mat >> 1, sub = (mat & 1) * 2;
            wrow = (const bf16_t*)(ws + WS_WF1) + ((size_t)mat * 5632 + n0) * D; shift = MOD + (size_t)layer * 5 * 9216 + (3 * sub) * 1024; dst = (float*)(ws + WS_SW) + (size_t)mat * 5 * 5632 + n0; N = 5632; }
        else if (ck < C_F1 + C_EI) { const int q = ck - C_F1, jj = q / 112, n0 = (q % 112) * 16;
            wrow = (const bf16_t*)(ws + WS_WEI) + ((size_t)jj * 1792 + n0) * D; shift = MOD + (size_t)(2 * jj) * 5 * 9216 + 3 * 1024; dst = (float*)(ws + WS_SW) + SW_EI + (size_t)jj * 5 * 1792 + n0; N = 1792; }
        else { const int q = ck - C_F1 - C_EI, jj = q / 128, n0 = (q % 128) * 16;
            wrow = (const bf16_t*)(ws + WS_WOI) + ((size_t)jj * 2048 + n0) * D; shift = MOD + (size_t)(2 * jj + 1) * 5 * 9216 + 3 * 1024; dst = (float*)(ws + WS_SW) + SW_OI + (size_t)jj * 5 * 2048 + n0; N = 2048; }
        const bf16_t* wp = wrow + (size_t)fr * D + fq * 8;
        const float* sp = shift + (size_t)(fr < 5 ? fr : 4) * 9216 + fq * 8;
        const float msk = fr < 5 ? 1.f : 0.f;
        f32x4 acc = (f32x4){0.f, 0.f, 0.f, 0.f};
#pragma unroll 1
        for (int kb = 0; kb < 32; kb += 4) {
            u32x4 bw[4]; f32x4 s0[4], s1[4];
#pragma unroll
            for (int i = 0; i < 4; ++i) { bw[i] = *(const u32x4*)(wp + (kb + i) * 32); s0[i] = *(const f32x4*)(sp + (kb + i) * 32); s1[i] = *(const f32x4*)(sp + (kb + i) * 32 + 4); }
#pragma unroll
            for (int i = 0; i < 4; ++i) {
                const f32x4 a0 = s0[i] * msk, a1 = s1[i] * msk;
                u32x4 aw; aw.x = cvt_pk_bf16(a0[0], a0[1]); aw.y = cvt_pk_bf16(a0[2], a0[3]); aw.z = cvt_pk_bf16(a1[0], a1[1]); aw.w = cvt_pk_bf16(a1[2], a1[3]);
                acc = __builtin_amdgcn_mfma_f32_16x16x32_bf16(__builtin_bit_cast(bf16x8, aw), __builtin_bit_cast(bf16x8, bw[i]), acc, 0, 0, 0);
            }
        }
        if (fq == 0) { dst[fr] = acc[0]; dst[(size_t)N + fr] = acc[1]; dst[(size_t)2 * N + fr] = acc[2]; dst[(size_t)3 * N + fr] = acc[3]; }
        else if (fq == 1) dst[(size_t)4 * N + fr] = acc[0];
    }
}

__device__ __noinline__ void attn_unit(const bf16_t* Q, int qrow0, int h, const bf16_t* Kb, const bf16_t* VT, int Lk, bf16_t* O, unsigned char* lds) {
    constexpr int KB = 18432, BUF = 35840, VP = 272;
    const int tid = threadIdx.x, wave = tid >> 6, lane = tid & 63, fr = lane & 15, fq = lane >> 4;
    const bf16_t* qp = Q + (size_t)(qrow0 + wave * 16 + fr) * 512 + h * 64 + fq * 8;
    const bf16x8 qf0 = *(const bf16x8*)qp, qf1 = *(const bf16x8*)(qp + 32);
    f32x4 o[4];
#pragma unroll
    for (int i = 0; i < 4; ++i) o[i] = (f32x4){0.f, 0.f, 0.f, 0.f};
    float mrun = -1e30f, lrun = 0.f;
    const int srow = tid >> 3, sch = tid & 7;
    const bf16_t* kg = Kb + srow * 64 + sch * 8;
    const bf16_t* vg = VT + (size_t)srow * Lk + sch * 8;
    const unsigned slk = srow * 144 + sch * 16, slv = KB + srow * VP + sch * 16;
    u32x4 kr0 = *(const u32x4*)kg, kr1 = *(const u32x4*)(kg + 64 * 64), vr0 = *(const u32x4*)vg, vr1 = *(const u32x4*)(vg + 64);
    *(u32x4*)(lds + slk) = kr0; *(u32x4*)(lds + slk + 64 * 144) = kr1; *(u32x4*)(lds + slv) = vr0; *(u32x4*)(lds + slv + 128) = vr1;
    __syncthreads();
    const int nt = Lk >> 7;
    for (int t = 0; t < nt; ++t) {
        const int cur = t & 1;
        if (t + 1 < nt) { const bf16_t* kn = kg + (size_t)(t + 1) * 128 * 64; const bf16_t* vn = vg + (t + 1) * 128;
            kr0 = *(const u32x4*)kn; kr1 = *(const u32x4*)(kn + 64 * 64); vr0 = *(const u32x4*)vn; vr1 = *(const u32x4*)(vn + 64); }
        const unsigned char* Kt = lds + cur * BUF; const unsigned char* Vt = Kt + KB;
        f32x4 s[8];
#pragma unroll
        for (int u = 0; u < 8; ++u) {
            const int krow = (u >> 1) * 32 + 8 * (fr >> 2) + 4 * (u & 1) + (fr & 3);
            const bf16x8 a0 = *(const bf16x8*)(Kt + krow * 144 + fq * 16), a1 = *(const bf16x8*)(Kt + krow * 144 + 64 + fq * 16);
            s[u] = __builtin_amdgcn_mfma_f32_16x16x32_bf16(a0, qf0, (f32x4){0.f, 0.f, 0.f, 0.f}, 0, 0, 0);
            s[u] = __builtin_amdgcn_mfma_f32_16x16x32_bf16(a1, qf1, s[u], 0, 0, 0);
        }
        float mx = s[0][0];
#pragma unroll
        for (int u = 0; u < 8; ++u)
#pragma unroll
            for (int j = 0; j < 4; ++j) mx = fmaxf(mx, s[u][j]);
        mx = fmaxf(mx, __shfl_xor(mx, 16)); mx = fmaxf(mx, __shfl_xor(mx, 32));
        const float mnew = fmaxf(mrun, mx), alpha = __builtin_amdgcn_exp2f(mrun - mnew); mrun = mnew;
        float ls = 0.f;
#pragma unroll
        for (int u = 0; u < 8; ++u)
#pragma unroll
            for (int j = 0; j < 4; ++j) { s[u][j] = __builtin_amdgcn_exp2f(s[u][j] - mnew); ls += s[u][j]; }
        lrun = lrun * alpha + ls;
#pragma unroll
        for (int i = 0; i < 4; ++i) o[i] = o[i] * alpha;
#pragma unroll
        for (int g2 = 0; g2 < 4; ++g2) {
            u32x4 pw; pw.x = cvt_pk_bf16(s[2 * g2][0], s[2 * g2][1]); pw.y = cvt_pk_bf16(s[2 * g2][2], s[2 * g2][3]); pw.z = cvt_pk_bf16(s[2 * g2 + 1][0], s[2 * g2 + 1][1]); pw.w = cvt_pk_bf16(s[2 * g2 + 1][2], s[2 * g2 + 1][3]);
            const bf16x8 pf = __builtin_bit_cast(bf16x8, pw);
#pragma unroll
            for (int dt = 0; dt < 4; ++dt) {
                const bf16x8 vf = *(const bf16x8*)(Vt + (dt * 16 + fr) * VP + g2 * 64 + fq * 16);
                o[dt] = __builtin_amdgcn_mfma_f32_16x16x32_bf16(vf, pf, o[dt], 0, 0, 0);
            }
        }
        if (t + 1 < nt) { unsigned char* nb = lds + (cur ^ 1) * BUF; *(u32x4*)(nb + slk) = kr0; *(u32x4*)(nb + slk + 64 * 144) = kr1; *(u32x4*)(nb + slv) = vr0; *(u32x4*)(nb + slv + 128) = vr1; }
        __syncthreads();
    }
    lrun += __shfl_xor(lrun, 16); lrun += __shfl_xor(lrun, 32);
    const float inv = 1.f / lrun;
    bf16_t* op = O + (size_t)(qrow0 + wave * 16 + fr) * D + h * 64 + fq * 4;
#pragma unroll
    for (int dt = 0; dt < 4; ++dt) { u32x2 w; w.x = cvt_pk_bf16(o[dt][0] * inv, o[dt][1] * inv); w.y = cvt_pk_bf16(o[dt][2] * inv, o[dt][3] * inv); *(u32x2*)(op + dt * 16) = w; }
}

#define GAS __attribute__((address_space(1)))
template <class P> __device__ __forceinline__ GAS P* uniform_ptr(P* p) {
    const unsigned long long v = (unsigned long long)p; const unsigned lo = __builtin_amdgcn_readfirstlane((unsigned)v), hi = __builtin_amdgcn_readfirstlane((unsigned)(v >> 32));
    return (GAS P*)(((unsigned long long)hi << 32) | lo);
}
__device__ __forceinline__ void conv_rows(GAS const _Float16* glu, int u, int ch, float (&gv)[46]) {
    const int t0 = u * 16; int bs, be;
    if (t0 < TP) { bs = t0 & ~255; be = bs + 256; } else { bs = TP + ((t0 - TP) & ~1023); be = bs + 1024; }
#pragma unroll
    for (int r = 0; r < 46; ++r) {
        const int tr = t0 - 15 + r; const int trc = __builtin_amdgcn_readfirstlane(tr < bs ? bs : (tr >= be ? be - 1 : tr));
        GAS const _Float16* rowp = glu + (size_t)trc * 512;
        gv[r] = (float)rowp[(unsigned)ch];
    }
}
__device__ __forceinline__ void conv_phase(const float* glu_, const float* cw_, const float* cb, const float* cng, const float* cnb, bf16_t* MIX_, unsigned char* lds, int G_) {
    const int ch = threadIdx.x, lane = ch & 63, wave = ch >> 6;
    GAS const _Float16* glu = (GAS const _Float16*)uniform_ptr(glu_); GAS const float* cw = uniform_ptr(cw_); GAS bf16_t* MIX = uniform_ptr(MIX_); const int G = __builtin_amdgcn_readfirstlane(G_);
    float* tile = (float*)lds;
    float* stat = tile + 16 * 512;
    const float bias = cb[ch], g = cng[ch], b = cnb[ch];
    int u = blockIdx.x;
    if (u >= 768) return;
    for (; u < 768; u += G) {
        float gv[46];
        conv_rows(glu, u, ch, gv);
        const int t0 = u * 16; int bs, be;
        if (t0 < TP) { bs = t0 & ~255; be = bs + 256; } else { bs = TP + ((t0 - TP) & ~1023); be = bs + 1024; }
#pragma unroll
        for (int r = 0; r < 46; ++r) { const int tr = t0 - 15 + r; gv[r] = (tr >= bs && tr < be) ? gv[r] : 0.f; }
        float out[16];
#pragma unroll
        for (int i = 0; i < 16; ++i) out[i] = bias;
#pragma unroll
        for (int tap = 0; tap < 31; ++tap) {
            const float w = (cw + tap * 512)[(unsigned)ch];
#pragma unroll
            for (int i = 0; i < 16; ++i) out[i] += w * gv[i + tap];
        }
#pragma unroll
        for (int i = 0; i < 16; ++i) tile[i * 512 + ch] = out[i];
        __syncthreads();
#pragma unroll
        for (int tk = 0; tk < 2; ++tk) {
            const int tok = wave * 2 + tk;
            const f32x4 a = *(const f32x4*)(tile + tok * 512 + lane * 8), c = *(const f32x4*)(tile + tok * 512 + lane * 8 + 4);
            float s1 = a[0] + a[1] + a[2] + a[3] + c[0] + c[1] + c[2] + c[3];
            float s2 = a[0] * a[0] + a[1] * a[1] + a[2] * a[2] + a[3] * a[3] + c[0] * c[0] + c[1] * c[1] + c[2] * c[2] + c[3] * c[3];
#pragma unroll
            for (int o = 1; o < 64; o <<= 1) { s1 += __shfl_xor(s1, o); s2 += __shfl_xor(s2, o); }
            if (lane == 0) { const float mu = s1 * (1.f / 512.f), var = fmaxf(s2 * (1.f / 512.f) - mu * mu, 0.f); stat[tok * 2] = mu; stat[tok * 2 + 1] = rsqrtf(var + 1e-5f); }
        }
        __syncthreads();
#pragma unroll
        for (int i = 0; i < 16; ++i) {
            const float y = (out[i] - stat[2 * i]) * stat[2 * i + 1] * g + b;
            MIX[(size_t)(t0 + i) * D + 512 + ch] = f2bf(siluf_(y));
        }
        __syncthreads();
    }
}

__device__ __noinline__ void sgu_unit(const float* V, const bf16_t* U, int t0, int g, const float* sw  , const float* sb  ,
                                          const float* sng, const float* snb, bf16_t* MIX, unsigned char* lds) {
    const int tid = threadIdx.x, wave = tid >> 6, lane = tid & 63, fr = lane & 15, fq = lane >> 4;
    bf16_t* vT = (bf16_t*)lds;
    bf16_t* wS = vT + 128 * 136;
    float* st = (float*)(wS + 128 * 136);
#pragma unroll 1
    for (int hb = 0; hb < 2; ++hb) {
        f32x4 a[8], b[8];
#pragma unroll
        for (int i = 0; i < 8; ++i) { const bf16_t* vr = (const bf16_t*)V + (size_t)(t0 + wave * 16 + hb * 8 + i) * 512 + lane * 8; unpack8_f16(*(const u32x4*)vr, a[i], b[i]); }
        float s1[8], s2[8];
#pragma unroll
        for (int i = 0; i < 8; ++i) { s1[i] = a[i][0] + a[i][1] + a[i][2] + a[i][3] + b[i][0] + b[i][1] + b[i][2] + b[i][3];
            s2[i] = a[i][0] * a[i][0] + a[i][1] * a[i][1] + a[i][2] * a[i][2] + a[i][3] * a[i][3] + b[i][0] * b[i][0] + b[i][1] * b[i][1] + b[i][2] * b[i][2] + b[i][3] * b[i][3]; }
#pragma unroll
        for (int o = 1; o < 64; o <<= 1) {
#pragma unroll
            for (int i = 0; i < 8; ++i) { s1[i] += __shfl_xor(s1[i], o); s2[i] += __shfl_xor(s2[i], o); }
        }
#pragma unroll
        for (int i = 0; i < 8; ++i) if (lane == i) { const float mu = s1[i] * (1.f / 512.f), var = fmaxf(s2[i] * (1.f / 512.f) - mu * mu, 0.f); const int q = wave * 16 + hb * 8 + i; st[q * 2] = mu; st[q * 2 + 1] = rsqrtf(var + 1e-5f); }
    }
    for (int e = tid; e < 128 * 16; e += 512) { const int pp = e >> 4, q8 = (e & 15) * 8;
        const f32x4 a = *(const f32x4*)(sw + pp * 128 + q8), b = *(const f32x4*)(sw + pp * 128 + q8 + 4);
        u32x4 w; w.x = cvt_pk_bf16(a[0], a[1]); w.y = cvt_pk_bf16(a[2], a[3]); w.z = cvt_pk_bf16(b[0], b[1]); w.w = cvt_pk_bf16(b[2], b[3]);
        *(u32x4*)(wS + pp * 136 + q8) = w; }
    __syncthreads();
    for (int e = tid; e < 128 * 16; e += 512) { const int q = e & 127, c8 = (e >> 7) * 8;
        const bf16_t* vr = (const bf16_t*)V + (size_t)(t0 + q) * 512 + g * 128 + c8;
        f32x4 a, b; unpack8_f16(*(const u32x4*)vr, a, b);
        const float mu = st[q * 2], rs = st[q * 2 + 1];
        const f32x4 ga = *(const f32x4*)(sng + g * 128 + c8), gb = *(const f32x4*)(sng + g * 128 + c8 + 4), ba = *(const f32x4*)(snb + g * 128 + c8), bb = *(const f32x4*)(snb + g * 128 + c8 + 4);
        const f32x4 ya = (a - mu) * rs * ga + ba, yb = (b - mu) * rs * gb + bb;
#pragma unroll
        for (int i = 0; i < 4; ++i) { vT[(c8 + i) * 136 + q] = f2bf(ya[i]); vT[(c8 + 4 + i) * 136 + q] = f2bf(yb[i]); }
    }
    __syncthreads();
    f32x4 acc[8];
#pragma unroll
    for (int i = 0; i < 8; ++i) acc[i] = (f32x4){0.f, 0.f, 0.f, 0.f};
#pragma unroll
    for (int kk = 0; kk < 4; ++kk) {
        const bf16x8 bfr = *(const bf16x8*)(wS + (wave * 16 + fr) * 136 + kk * 32 + fq * 8);
#pragma unroll
        for (int ct = 0; ct < 8; ++ct) {
            const bf16x8 afr = *(const bf16x8*)(vT + (ct * 16 + fr) * 136 + kk * 32 + fq * 8);
            acc[ct] = __builtin_amdgcn_mfma_f32_16x16x32_bf16(afr, bfr, acc[ct], 0, 0, 0);
        }
    }
    const int pp = wave * 16 + fr; const float bias = sb[pp];
#pragma unroll
    for (int ct = 0; ct < 8; ++ct) {
        const int c = g * 128 + ct * 16 + fq * 4;
        const u32x2 uu = *(const u32x2*)(U + (size_t)(t0 + pp) * 512 + c);
        const float u0 = bf2f(uu.x & 0xffffu), u1 = bf2f(uu.x >> 16), u2 = bf2f(uu.y & 0xffffu), u3 = bf2f(uu.y >> 16);
        u32x2 w; w.x = cvt_pk_bf16(u0 * (acc[ct][0] + bias), u1 * (acc[ct][1] + bias)); w.y = cvt_pk_bf16(u2 * (acc[ct][2] + bias), u3 * (acc[ct][3] + bias));
        *(u32x2*)(MIX + (size_t)(t0 + pp) * D + 512 + c) = w;
    }
    __syncthreads();
}


__global__ void __launch_bounds__(512, 2) mega(Params p_unused) {
    extern __shared__ __attribute__((aligned(16))) unsigned char lds[];
    cg::grid_group grid = cg::this_grid();
    const int hi = kparams()->ph_hi;
    volatile LAS unsigned* bst = (volatile LAS unsigned*)((LAS unsigned char*)lds + 131072 + 64);
    if (threadIdx.x == 0) { bst[0] = 0u; bst[1] = 0u;
        if (hi - kparams()->ph_lo > 1) (void)xb_add(&((unsigned*)(KWS() + WS_BAR))[XB_XCNT(xb_xcc_id())], 1u); }
    __syncthreads();
    for (int ph = kparams()->ph_lo; ph < hi; ++ph) {
        const int G = gridDim.x;
        LAS unsigned char* ldsl = (LAS unsigned char*)lds;
        if (ph == 0) {
#ifndef NO_PRO
            for (int rp = 0; rp < DUPN(1); ++rp) { prologue((const Params*)kparams(), lds, G); __syncthreads(); }
#endif
        } else if (ph == 1) {
            if (blockIdx.x & 1) { shiftw_phase((const Params*)kparams(), G); pre_phase((const Params*)kparams(), G); }
            else { pre_phase((const Params*)kparams(), G); shiftw_phase((const Params*)kparams(), G); }
        } else {
            const int q = ph - 2, layer = q / 7, r = q % 7, j = layer >> 1;
            const int sub = (r < 2) ? 0 : (r < 5 ? 1 : 2), sidx = layer * 3 + sub;
            const bool first = (layer == 0 && sub == 0), lastsub = (layer == 3 && sub == 2);
            if (r == 0 || r == 5) {
#ifndef NO_F1
                unsigned char* ws = KWS();
                const int mat = layer * 2 + (sub >> 1);
                constexpr int M1 = 46 * 256;
                for (int rp = 0; rp < DUPN(4); ++rp) {
                    { pg8::Gemm g{(const bf16_t*)(ws + WS_H), (const bf16_t*)(ws + WS_WF1) + (size_t)mat * 5632 * D, M1, 5632, D}; pg8::StaticOrder S; S.init(M1, 5632, G, blockIdx.x, 256);
                      const EpiSwiglu<256> E{(bf16_t*)(ws + WS_HID), (const float*)(ws + WS_RSS) + (size_t)sidx * T, (const float*)(ws + WS_SW) + (size_t)mat * 5 * 5632, 0};
                      pg8::gemm_phase<256>(ldsl, g, S, E); }
                    { pg8::Gemm g{(const bf16_t*)(ws + WS_H) + (size_t)M1 * D, (const bf16_t*)(ws + WS_WF1) + (size_t)mat * 5632 * D, T - M1, 5632, D}; pg8::StaticOrder S; S.init(T - M1, 5632, G, G - 1 - (int)blockIdx.x, 128);
                      const EpiSwiglu<128> E{(bf16_t*)(ws + WS_HID), (const float*)(ws + WS_RSS) + (size_t)sidx * T, (const float*)(ws + WS_SW) + (size_t)mat * 5 * 5632, M1};
                      pg8::gemm_phase<128>(ldsl, g, S, E); }
                }
#endif
            } else if (r == 1 || r == 6 || r == 4) {
#ifndef NO_F2
                unsigned char* ws = KWS();
                const int mat = layer * 2 + (sub >> 1);
                pg8::Gemm g;
                if (r == 4) g = pg8::Gemm{(const bf16_t*)(ws + WS_MIX), (const bf16_t*)(ws + ((layer & 1) ? WS_WOO : WS_WEO)) + (size_t)j * D * D, T, D, D};
                else g = pg8::Gemm{(const bf16_t*)(ws + WS_HID), (const bf16_t*)(ws + WS_WF2) + (size_t)mat * D * FFN, T, D, FFN};
                pg8::StaticOrder S; S.init(T, D, G, blockIdx.x, GT);
                const EpiResid<GT> ER{layer, sub};
                pg8::gemm_phase<GT>(ldsl, g, S, ER);
#endif
            } else if ((layer & 1) == 0) {
                if (r == 2) {
#ifndef NO_EI
                    unsigned char* ws = KWS();
                    pg8::Gemm g{(const bf16_t*)(ws + WS_H), (const bf16_t*)(ws + WS_WEI) + (size_t)j * 1792 * D, T, 1792, D}; pg8::StaticOrder S; S.init(T, 1792, G, blockIdx.x, GT);
                    const EpiEvenIn<GT> E{j, sidx};
                    for (int rp = 0; rp < DUPN(8); ++rp) pg8::gemm_phase<GT>(ldsl, g, S, E);
#endif
                } else {
#ifndef NO_ATT
                    for (int rp = 0; rp < DUPN(16); ++rp) {
                    unsigned char* ws = KWS();
                    const bf16_t* Ks = (const bf16_t*)(ws + WS_KS) + (size_t)j * 4 * 2 * 1536 * 64; const bf16_t* VsT = (const bf16_t*)(ws + WS_VST) + (size_t)j * 4 * 2 * 64 * 1536;
                    bf16_t* MIX = (bf16_t*)(ws + WS_MIX);
                    for (int u = blockIdx.x; u < 768; u += G) {
                        if (u < 256) { const int b = u >> 6, h = (u >> 3) & 7, qt = u & 7, kvh = h >> 2;
                            attn_unit((const bf16_t*)(ws + WS_Q), TP + b * 1024 + qt * 128, h, Ks + (size_t)(b * 2 + kvh) * 1536 * 64, VsT + (size_t)(b * 2 + kvh) * 64 * 1536, 1536, MIX, lds);
                        } else { const int v = u - 256, b = v >> 4, h = (v >> 1) & 7, qt = v & 1, kvh = h >> 2;
                            attn_unit((const bf16_t*)(ws + WS_Q), b * 256 + qt * 128, h, (const bf16_t*)(ws + WS_KP) + (size_t)(b * 2 + kvh) * 256 * 64, (const bf16_t*)(ws + WS_VPT) + (size_t)(b * 2 + kvh) * 64 * 256, 256, MIX, lds); }
                    }
                    }
#endif
#ifndef NO_CONV
                    for (int rp = 0; rp < DUPN(32); ++rp) {
                    unsigned char* ws = KWS();
                    conv_phase((const float*)(ws + WS_GLU), KIN(15) + (size_t)j * 31 * 512, KIN(16) + j * 512, KIN(17) + j * 512, KIN(18) + j * 512, (bf16_t*)(ws + WS_MIX), lds, G);
                    }
#endif
                }
            } else {
                if (r == 2) {
#ifndef NO_OI
                    unsigned char* ws = KWS();
                    pg8::Gemm g{(const bf16_t*)(ws + WS_H), (const bf16_t*)(ws + WS_WOI) + (size_t)j * 2048 * D, T, 2048, D}; pg8::StaticOrder S; S.init(T, 2048, G, blockIdx.x, GT);
                    const EpiOddIn<GT> E{(bf16_t*)(ws + WS_FTP), (bf16_t*)(ws + WS_FTS), (bf16_t*)(ws + WS_U), (float*)(ws + WS_V), (const float*)(ws + WS_RSS) + (size_t)sidx * T, (const float*)(ws + WS_SW) + SW_OI + (size_t)j * 5 * 2048};
                    for (int rp = 0; rp < DUPN(8); ++rp) pg8::gemm_phase<GT>(ldsl, g, S, E);
#endif
                } else {
#ifndef NO_FOUR
                    for (int which = 0; which < 2 * DUPN(64); ++which) {
                        unsigned char* ws = KWS();
                        pg8::Gemm g; pg8::StaticOrder S; EpiFourier E;
                        if ((which & 1) == 0) { g = pg8::Gemm{(const bf16_t*)(ws + WS_D1024), (const bf16_t*)(ws + WS_FTS), 1024, 2048, 2048}; S.init(1024, 2048, G, blockIdx.x); E = EpiFourier{(bf16_t*)(ws + WS_MIX), TP, 1024}; }
                        else { g = pg8::Gemm{(const bf16_t*)(ws + WS_D256), (const bf16_t*)(ws + WS_FTP), 256, 16384, 512}; S.init(256, 16384, G, (blockIdx.x + G - (32 % G)) % G); E = EpiFourier{(bf16_t*)(ws + WS_MIX), 0, 256}; }
                        pg8::gemm_phase<256>(ldsl, g, S, E);
                    }
#endif
#ifndef NO_SGU
                    for (int rp = 0; rp < DUPN(128); ++rp) {
                    unsigned char* ws = KWS();
                    const bool g256 = (G == 256);
                    for (int u = g256 ? (blockIdx.x >= 32 ? 255 - (int)blockIdx.x : 384) : (int)blockIdx.x; u < 384; u += (g256 ? 224 : G)) {
                        const int ch = u >> 2, g = u & 3;
                        sgu_unit((const float*)(ws + WS_V), (const bf16_t*)(ws + WS_U), ch * 128, g, KIN(23) + ((size_t)j * 4 + g) * 128 * 128, KIN(24) + (j * 4 + g) * 128,
                                 KIN(21) + j * 512, KIN(22) + j * 512, (bf16_t*)(ws + WS_MIX), lds);
                    }
                    }
#endif
                }
            }
        }
        if (ph + 1 < hi) {
            unsigned* bar = (unsigned*)(KWS() + WS_BAR);
            if (hi > (1 << 20)) grid.sync();
            xcd_barrier(bar, bst); if (DUP_MASK & 256) xcd_barrier(bar, bst);
        }
    }
}

extern "C" void kernel_launch(void* const* d_in, const int* in_sizes, int n_in, void* d_out, int out_size, void* d_ws, size_t ws_size, hipStream_t stream) {
    static int grid = 0;
    if (grid == 0) {
        if (n_in != 25 || ws_size < WS_END) { fprintf(stderr, "kernel_launch: unexpected n_in %d / ws_size %zu\n", n_in, ws_size); grid = -1; return; }
        int dev = 0, cus = 0, per_cu = 0;
        hipGetDevice(&dev);
        hipDeviceGetAttribute(&cus, hipDeviceAttributeMultiprocessorCount, dev);
        if (hipFuncSetAttribute((const void*)mega, hipFuncAttributeMaxDynamicSharedMemorySize, LDS_BYTES) != hipSuccess) { fprintf(stderr, "kernel_launch: hipFuncSetAttribute failed\n"); grid = -1; return; }
        if (hipOccupancyMaxActiveBlocksPerMultiprocessor(&per_cu, (const void*)mega, 512, LDS_BYTES) != hipSuccess || per_cu < 1) { fprintf(stderr, "kernel_launch: occupancy query failed (%d)\n", per_cu); grid = -1; return; }
        grid = cus;
    }
    if (grid < 0) return;
    if (hipMemsetAsync((char*)d_ws + WS_BAR, 0, XCD_BAR_WORDS * 4, stream) != hipSuccess) { fprintf(stderr, "kernel_launch: hipMemsetAsync failed\n"); return; }
    Params p{};
    for (int i = 0; i < 25; ++i) p.in[i] = (const float*)d_in[i];
    p.out = (float*)d_out; p.ws = (unsigned char*)d_ws;
#if ONE_LAUNCH
    p.ph_lo = 0; p.ph_hi = NPH;
    void* args[] = {&p};
    hipError_t e = hipLaunchCooperativeKernel((const void*)mega, dim3(grid), dim3(512), args, LDS_BYTES, stream);
    if (e != hipSuccess) fprintf(stderr, "cooperative launch failed: %s (grid %d)\n", hipGetErrorString(e), grid);
#else
    for (int ph = 0; ph < NPH; ++ph) { p.ph_lo = ph; p.ph_hi = ph + 1; hipLaunchKernelGGL(mega, dim3(grid), dim3(512), LDS_BYTES, stream, p); }
#endif
}
```
